# Optimizing an MI355X kernel written in HIP

```python
import math
import jax, jax.numpy as jnp
from jax import lax
import numpy as np

D_MODEL = 1024
BATCH = 2
SEQ = 16384
DEPTH = 4

N_EVEN = (DEPTH + 1) // 2
N_ODD = DEPTH // 2
RMS_EPS = 1e-6
D_FF = -(-8 * D_MODEL // (3 * 256)) * 256
MIX_WIDTH = D_MODEL

POOL_WIDTH = MIX_WIDTH // 4
POOL_WINDOWS = (2, 4, 8, 16)
POOL_GROUPS = len(POOL_WINDOWS)
POOL_GROUP_DIM = POOL_WIDTH // POOL_GROUPS
SSD_WIDTH = MIX_WIDTH - POOL_WIDTH
SSD_HEAD_DIM = 64
SSD_HEADS = SSD_WIDTH // SSD_HEAD_DIM
SSD_GROUPS = 2
SSD_HEADS_PER_GROUP = SSD_HEADS // SSD_GROUPS
SSD_STATE = 128
SSD_CONV = 4
SSD_CHUNK = 128
SSD_BC_DIM = SSD_GROUPS * SSD_STATE
SSD_CONV_DIM = SSD_WIDTH + 2 * SSD_BC_DIM
EVEN_IN = POOL_WIDTH + SSD_WIDTH + SSD_CONV_DIM + SSD_HEADS

RWKV_WIDTH = MIX_WIDTH // 2
RWKV_HEAD_DIM = 64
RWKV_HEADS = RWKV_WIDTH // RWKV_HEAD_DIM
RWKV_DECAY_RANK = 64
RWKV_ICLR_RANK = 64
RWKV_GATE_RANK = 128
RWKV_IN = 3 * RWKV_WIDTH + RWKV_DECAY_RANK + RWKV_ICLR_RANK + RWKV_GATE_RANK
RWKV_GN_EPS = 64e-5
RWKV_DECAY_OFFSET = 0.5
LRU_WIDTH = MIX_WIDTH - RWKV_WIDTH
LRU_BLOCKS = 8
LRU_BLOCK_DIM = LRU_WIDTH // LRU_BLOCKS
LRU_CONV = 4
LRU_C = 8.0
ODD_IN = RWKV_IN + 2 * LRU_WIDTH

kernel_name = "hybrid_pool_ssd_rwkv7_rglru_trunk"


def rmsnorm(x, g):
    xf = x.astype(jnp.float32)
    y = xf * lax.rsqrt(jnp.mean(xf * xf, axis=-1, keepdims=True) + RMS_EPS)
    return (y * g.astype(jnp.float32)).astype(x.dtype)


def causal_depthwise_conv(x, w, b):
    k = w.shape[0]
    y = lax.conv_general_dilated(x, w[:, None, :], window_strides=(1,), padding=((k - 1, 0),),
                                 dimension_numbers=("NWC", "WIO", "NWC"),
                                 feature_group_count=x.shape[-1])
    return y + b


def swiglu(h, w_gate, w_up, w_down):
    return (jax.nn.silu(h @ w_gate) * (h @ w_up)) @ w_down


def pool_mixer(u, pool_w, pool_scale):
    bsz, s, _ = u.shape
    uf = u.astype(jnp.float32).reshape(bsz, s, POOL_GROUPS, POOL_GROUP_DIM)
    cs = jnp.cumsum(uf, axis=1)
    cs = jnp.concatenate([jnp.zeros_like(cs[:, :1]), cs], axis=1)
    pos = jnp.arange(1, s + 1, dtype=jnp.float32)
    pooled = []
    for gi, w in enumerate(POOL_WINDOWS):
        c = cs[:, :, gi]
        lo = jnp.concatenate([jnp.zeros_like(c[:, :w - 1]), c[:, :s + 1 - w]], axis=1)
        cnt = jnp.minimum(pos, float(w))[None, :, None]
        pooled.append((c[:, 1:] - lo) / cnt)
    pooled = jnp.stack(pooled, axis=2)
    d = (pooled - uf).astype(u.dtype)
    y = jnp.einsum("bsgc,gcd->bsgd", d, pool_w).reshape(bsz, s, POOL_WIDTH)
    return y * pool_scale


def ssd_chunked_scan(x, dt, a, bm, cm):
    bsz, s = x.shape[:2]
    nc = s // SSD_CHUNK
    L = SSD_CHUNK
    xc = (x * dt[..., None]).reshape(bsz, nc, L, SSD_GROUPS, SSD_HEADS_PER_GROUP, SSD_HEAD_DIM)
    bc = bm.reshape(bsz, nc, L, SSD_GROUPS, SSD_STATE)
    cc = cm.reshape(bsz, nc, L, SSD_GROUPS, SSD_STATE)
    da = jnp.transpose((dt * a).reshape(bsz, nc, L, SSD_GROUPS, SSD_HEADS_PER_GROUP), (0, 1, 3, 4, 2))
    cum = jnp.cumsum(da, axis=-1)
    seg = cum[..., :, None] - cum[..., None, :]
    mask = jnp.tril(jnp.ones((L, L), dtype=bool))
    decay = jnp.where(mask, jnp.exp(jnp.minimum(seg, 0.0)), 0.0)
    cb = jnp.einsum("bclgn,bcsgn->bcgls", cc, bc)
    y_diag = jnp.einsum("bcgls,bcgels,bcsgep->bclgep", cb, decay, xc)
    decay_to_end = jnp.exp(cum[..., -1:] - cum)
    chunk_states = jnp.einsum("bclgn,bcgel,bclgep->bcgepn", bc, decay_to_end, xc)
    chunk_decay = jnp.exp(cum[..., -1])

    def step(h, inp):
        st, dec = inp
        return h * dec[..., None, None] + st, h

    h0 = jnp.zeros((bsz, SSD_GROUPS, SSD_HEADS_PER_GROUP, SSD_HEAD_DIM, SSD_STATE), jnp.float32)
    _, prev = lax.scan(step, h0, (jnp.moveaxis(chunk_states, 1, 0), jnp.moveaxis(chunk_decay, 1, 0)))
    prev = jnp.moveaxis(prev, 0, 1)
    y_off = jnp.einsum("bclgn,bcgepn,bcgel->bclgep", cc, prev, jnp.exp(cum))
    return (y_diag + y_off).reshape(bsz, s, SSD_GROUPS, SSD_HEADS_PER_GROUP, SSD_HEAD_DIM)


def ssd_mixer(z, xbc, dt_raw, conv_w, conv_b, dt_bias, a_log, d_skip, norm_g):
    bsz, s, _ = z.shape
    f32 = jnp.float32
    xbc = jax.nn.silu(causal_depthwise_conv(xbc, conv_w, conv_b)).astype(f32)
    xh = xbc[..., :SSD_WIDTH].reshape(bsz, s, SSD_GROUPS, SSD_HEADS_PER_GROUP, SSD_HEAD_DIM)
    bm = xbc[..., SSD_WIDTH:SSD_WIDTH + SSD_BC_DIM].reshape(bsz, s, SSD_GROUPS, SSD_STATE)
    cm = xbc[..., SSD_WIDTH + SSD_BC_DIM:].reshape(bsz, s, SSD_GROUPS, SSD_STATE)
    dt = jax.nn.softplus(dt_raw.astype(f32) + dt_bias.astype(f32)).reshape(bsz, s, SSD_GROUPS, SSD_HEADS_PER_GROUP)
    a = -jnp.exp(a_log.astype(f32)).reshape(SSD_GROUPS, SSD_HEADS_PER_GROUP)
    y = ssd_chunked_scan(xh, dt, a, bm, cm)
    y = y + d_skip.astype(f32).reshape(SSD_GROUPS, SSD_HEADS_PER_GROUP)[:, :, None] * xh
    gsz = SSD_WIDTH // SSD_GROUPS
    y = y.reshape(bsz, s, SSD_GROUPS, gsz) * jax.nn.silu(z.astype(f32)).reshape(bsz, s, SSD_GROUPS, gsz)
    y = y * lax.rsqrt(jnp.mean(y * y, axis=-1, keepdims=True) + RMS_EPS)
    return (y.reshape(bsz, s, SSD_WIDTH) * norm_g.astype(f32)).astype(z.dtype)


def token_shift(p, mu):
    prev = jnp.concatenate([jnp.zeros_like(p[:, :1]), p[:, :-1]], axis=1)
    return p + mu * (prev - p)


def rwkv7_scan(r, w, k, v, kk, a):
    def step(st, inp):
        r_t, w_t, k_t, v_t, kk_t, a_t = inp
        sa = jnp.einsum("bhvk,bhk->bhv", st, -kk_t)
        st = (st * w_t[:, :, None, :] + sa[..., None] * (kk_t * a_t)[:, :, None, :]
              + v_t[..., None] * k_t[:, :, None, :])
        return st, jnp.einsum("bhvk,bhk->bhv", st, r_t)

    bsz = r.shape[0]
    s0 = jnp.zeros((bsz, RWKV_HEADS, RWKV_HEAD_DIM, RWKV_HEAD_DIM), jnp.float32)
    xs = tuple(jnp.moveaxis(t, 1, 0) for t in (r, w, k, v, kk, a))
    _, y = lax.scan(step, s0, xs)
    return jnp.moveaxis(y, 0, 1)


def rwkv7_mixer(p, mu, w0, w_up, a0, a_up, g_up, k_k, k_a, r_k, ln_g, ln_b):
    bsz, s, _ = p.shape
    f32 = jnp.float32
    p = token_shift(p, mu)
    o1, o2, o3 = RWKV_WIDTH, 2 * RWKV_WIDTH, 3 * RWKV_WIDTH
    o4, o5 = o3 + RWKV_DECAY_RANK, o3 + RWKV_DECAY_RANK + RWKV_ICLR_RANK
    r, k, v = p[..., :o1], p[..., o1:o2], p[..., o2:o3]
    wd, ad, gd = p[..., o3:o4], p[..., o4:o5], p[..., o5:]
    w_log = -jax.nn.softplus(-(w0 + jnp.tanh(wd) @ w_up).astype(f32)) - RWKV_DECAY_OFFSET
    decay = jnp.exp(-jnp.exp(w_log))
    a = jax.nn.sigmoid((a0 + ad @ a_up).astype(f32))
    g = (jax.nn.sigmoid(gd) @ g_up).astype(f32)
    heads = lambda t: t.astype(f32).reshape(bsz, s, RWKV_HEADS, RWKV_HEAD_DIM)
    r, k, v, decay, a = heads(r), heads(k), heads(v), heads(decay), heads(a)
    kk = k * k_k.astype(f32).reshape(RWKV_HEADS, RWKV_HEAD_DIM)
    kk = kk * lax.rsqrt(jnp.sum(kk * kk, axis=-1, keepdims=True) + 1e-12)
    k = k * (1.0 + (a - 1.0) * k_a.astype(f32).reshape(RWKV_HEADS, RWKV_HEAD_DIM))
    y = rwkv7_scan(r, decay, k, v, kk, a)
    mean = jnp.mean(y, axis=-1, keepdims=True)
    var = jnp.mean(jnp.square(y - mean), axis=-1, keepdims=True)
    y = ((y - mean) * lax.rsqrt(var + RWKV_GN_EPS)).reshape(bsz, s, RWKV_WIDTH)
    y = y * ln_g.astype(f32) + ln_b.astype(f32)
    bonus = jnp.sum(r * k * r_k.astype(f32), axis=-1, keepdims=True) * v
    y = y + bonus.reshape(bsz, s, RWKV_WIDTH)
    return (y * g).astype(p.dtype)


def _linear_combine(left, right):
    a_l, b_l = left
    a_r, b_r = right
    return a_l * a_r, a_r * b_l + b_r


def rglru_mixer(gate, xb, conv_w, conv_b, wa, ba, wx, bx, lam):
    bsz, s, _ = xb.shape
    f32 = jnp.float32
    xb = causal_depthwise_conv(xb, conv_w, conv_b)
    xblk = xb.reshape(bsz, s, LRU_BLOCKS, LRU_BLOCK_DIM)
    rg = jax.nn.sigmoid((jnp.einsum("bshi,hij->bshj", xblk, wa).reshape(bsz, s, LRU_WIDTH) + ba).astype(f32))
    ig = jax.nn.sigmoid((jnp.einsum("bshi,hij->bshj", xblk, wx).reshape(bsz, s, LRU_WIDTH) + bx).astype(f32))
    log_a = -LRU_C * rg * jax.nn.softplus(-lam.astype(f32))
    a = jnp.exp(log_a)
    mult = jnp.sqrt(-jnp.expm1(2.0 * log_a))
    b = mult * ig * xb.astype(f32)
    _, h = lax.associative_scan(_linear_combine, (a, b), axis=1)
    return (h * jax.nn.gelu(gate.astype(f32))).astype(xb.dtype)


def even_mixer(h, w_in, w_out, pool_w, pool_scale, conv_w, conv_b, dt_bias, a_log, d_skip, norm_g):
    p = h @ w_in
    o1 = POOL_WIDTH
    o2 = o1 + SSD_WIDTH
    o3 = o2 + SSD_CONV_DIM
    y_pool = pool_mixer(p[..., :o1], pool_w, pool_scale)
    y_ssd = ssd_mixer(p[..., o1:o2], p[..., o2:o3], p[..., o3:], conv_w, conv_b, dt_bias, a_log, d_skip, norm_g)
    return jnp.concatenate([y_pool, y_ssd], axis=-1) @ w_out


def odd_mixer(h, w_in, w_out, mu, w0, w_up, a0, a_up, g_up, k_k, k_a, r_k, ln_g, ln_b,
              lconv_w, lconv_b, wa, ba, wx, bx, lam):
    p = h @ w_in
    y_rwkv = rwkv7_mixer(p[..., :RWKV_IN], mu, w0, w_up, a0, a_up, g_up, k_k, k_a, r_k, ln_g, ln_b)
    y_lru = rglru_mixer(p[..., RWKV_IN:RWKV_IN + LRU_WIDTH], p[..., RWKV_IN + LRU_WIDTH:],
                        lconv_w, lconv_b, wa, ba, wx, bx, lam)
    return jnp.concatenate([y_rwkv, y_lru], axis=-1) @ w_out


def setup_inputs(seed: int = 0) -> dict:
    key = jax.random.key(seed)
    ks = jax.random.split(key, 48)
    f32 = jnp.float32
    nrm = lambda i, shape, scale: scale * jax.random.normal(ks[i], shape, f32)
    unif = lambda i, shape, lo, hi: jax.random.uniform(ks[i], shape, f32, lo, hi)
    E, O = N_EVEN, N_ODD
    dt0 = jnp.exp(unif(16, (E, SSD_HEADS), math.log(1e-3), math.log(1e-1)))
    lru_a = unif(40, (O, LRU_WIDTH), 0.9, 0.999) ** (1.0 / LRU_C)
    return {
        "x": nrm(0, (BATCH, SEQ, D_MODEL), 1.0),
        "mix_norm_g": 1.0 + nrm(1, (DEPTH, D_MODEL), 0.05),
        "ffn_norm_g": 1.0 + nrm(2, (DEPTH, D_MODEL), 0.05),
        "ffn_w_gate": nrm(3, (DEPTH, D_MODEL, D_FF), D_MODEL ** -0.5),
        "ffn_w_up": nrm(4, (DEPTH, D_MODEL, D_FF), D_MODEL ** -0.5),
        "ffn_w_down": nrm(5, (DEPTH, D_FF, D_MODEL), 0.5 * D_FF ** -0.5),
        "final_norm_g": 1.0 + nrm(6, (D_MODEL,), 0.05),
        "ev_w_in": nrm(7, (E, D_MODEL, EVEN_IN), D_MODEL ** -0.5),
        "ev_w_out": nrm(8, (E, MIX_WIDTH, D_MODEL), 0.5 * MIX_WIDTH ** -0.5),
        "pool_w": nrm(9, (E, POOL_GROUPS, POOL_GROUP_DIM, POOL_GROUP_DIM), POOL_GROUP_DIM ** -0.5),
        "pool_scale": 1.0 + nrm(10, (E, POOL_WIDTH), 0.05),
        "ssd_conv_w": nrm(11, (E, SSD_CONV, SSD_CONV_DIM), 0.5),
        "ssd_conv_b": nrm(12, (E, SSD_CONV_DIM), 0.02),
        "ssd_dt_bias": dt0 + jnp.log(-jnp.expm1(-dt0)),
        "ssd_a_log": jnp.log(unif(13, (E, SSD_HEADS), 1.0, 16.0)),
        "ssd_d": 1.0 + nrm(14, (E, SSD_HEADS), 0.1),
        "ssd_norm_g": 1.0 + nrm(15, (E, SSD_WIDTH), 0.05),
        "od_w_in": nrm(20, (O, D_MODEL, ODD_IN), D_MODEL ** -0.5),
        "od_w_out": nrm(21, (O, MIX_WIDTH, D_MODEL), 0.5 * MIX_WIDTH ** -0.5),
        "rwkv_mu": unif(22, (O, RWKV_IN), 0.0, 1.0),
        "rwkv_w0": unif(23, (O, RWKV_WIDTH), -5.0, 1.0),
        "rwkv_w_up": nrm(24, (O, RWKV_DECAY_RANK, RWKV_WIDTH), 0.1),
        "rwkv_a0": nrm(25, (O, RWKV_WIDTH), 0.5),
        "rwkv_a_up": nrm(26, (O, RWKV_ICLR_RANK, RWKV_WIDTH), 0.1),
        "rwkv_g_up": nrm(27, (O, RWKV_GATE_RANK, RWKV_WIDTH), RWKV_GATE_RANK ** -0.5),
        "rwkv_k_k": 0.85 + nrm(28, (O, RWKV_WIDTH), 0.05),
        "rwkv_k_a": 1.0 + nrm(29, (O, RWKV_WIDTH), 0.05),
        "rwkv_r_k": nrm(30, (O, RWKV_HEADS, RWKV_HEAD_DIM), 0.1),
        "rwkv_ln_g": 1.0 + nrm(31, (O, RWKV_WIDTH), 0.05),
        "rwkv_ln_b": nrm(32, (O, RWKV_WIDTH), 0.02),
        "lru_conv_w": nrm(33, (O, LRU_CONV, LRU_WIDTH), 0.5),
        "lru_conv_b": nrm(34, (O, LRU_WIDTH), 0.02),
        "lru_wa": nrm(35, (O, LRU_BLOCKS, LRU_BLOCK_DIM, LRU_BLOCK_DIM), LRU_BLOCK_DIM ** -0.5),
        "lru_ba": nrm(36, (O, LRU_WIDTH), 0.02),
        "lru_wx": nrm(37, (O, LRU_BLOCKS, LRU_BLOCK_DIM, LRU_BLOCK_DIM), LRU_BLOCK_DIM ** -0.5),
        "lru_bx": nrm(38, (O, LRU_WIDTH), 0.02),
        "lru_lambda": jnp.log(lru_a) - jnp.log1p(-lru_a),
    }


def reference(x, mix_norm_g, ffn_norm_g, ffn_w_gate, ffn_w_up, ffn_w_down, final_norm_g,
              ev_w_in, ev_w_out, pool_w, pool_scale, ssd_conv_w, ssd_conv_b, ssd_dt_bias, ssd_a_log,
              ssd_d, ssd_norm_g, od_w_in, od_w_out, rwkv_mu, rwkv_w0, rwkv_w_up, rwkv_a0, rwkv_a_up,
              rwkv_g_up, rwkv_k_k, rwkv_k_a, rwkv_r_k, rwkv_ln_g, rwkv_ln_b, lru_conv_w, lru_conv_b,
              lru_wa, lru_ba, lru_wx, lru_bx, lru_lambda):
    h = x
    for layer in range(DEPTH):
        i = layer // 2
        hn = rmsnorm(h, mix_norm_g[layer])
        if layer % 2 == 0:
            mix = even_mixer(hn, ev_w_in[i], ev_w_out[i], pool_w[i], pool_scale[i], ssd_conv_w[i],
                             ssd_conv_b[i], ssd_dt_bias[i], ssd_a_log[i], ssd_d[i], ssd_norm_g[i])
        else:
            mix = odd_mixer(hn, od_w_in[i], od_w_out[i], rwkv_mu[i], rwkv_w0[i], rwkv_w_up[i], rwkv_a0[i],
                            rwkv_a_up[i], rwkv_g_up[i], rwkv_k_k[i], rwkv_k_a[i], rwkv_r_k[i], rwkv_ln_g[i],
                            rwkv_ln_b[i], lru_conv_w[i], lru_conv_b[i], lru_wa[i], lru_ba[i], lru_wx[i],
                            lru_bx[i], lru_lambda[i])
        h = h + mix
        hn = rmsnorm(h, ffn_norm_g[layer])
        h = h + swiglu(hn, ffn_w_gate[layer], ffn_w_up[layer], ffn_w_down[layer])
    return rmsnorm(h, final_norm_g)
```

```cpp
#include <hip/hip_runtime.h>
#include <hip/hip_cooperative_groups.h>
#include <cstdio>
namespace cg = cooperative_groups;

typedef unsigned short bf16_t;
constexpr int M_TOK = 32768, SEQ = 16384, DM = 1024, FF = 2816, PP = 2816;
constexpr int LDS_BYTES = 147456;
constexpr int NIN = 37;

constexpr size_t MiB = 1048576;
constexpr size_t WS_WIN = 0, WS_WOUT = 5767168, WS_WGU = 7864320, WS_WDN = 19398656;
constexpr size_t WS_HN = 24 * MiB, WS_P = 88 * MiB, WS_SC = 264 * MiB, WS_MISC = 504 * MiB, WS_END = 512 * MiB;
constexpr size_t SC_XBC = 0, SC_ST = 80 * MiB, SC_CB = 176 * MiB, SC_PD = 208 * MiB;
constexpr size_t SC_W = 0, SC_KK = 64 * MiB, SC_B = 96 * MiB, SC_Y = 128 * MiB;
constexpr size_t MS_BND = 0, MS_AGG = 4325376, MS_BS = MS_AGG + 1048576, MS_CDEC = MS_BS + 1048576;

struct Params { const float* in[NIN]; float* out; unsigned char* ws; int ph_lo, ph_hi; };
struct InArr { const Params* p; int z; __device__ __forceinline__ const float* operator[](int k) const { return p->in[k + z]; } };
struct Ctx { InArr in; float* out; unsigned char* ws; };

__device__ __forceinline__ int ltid() { int t = threadIdx.x; asm volatile("" : "+v"(t)); return t; }
__device__ __forceinline__ int lbid() { int t = blockIdx.x; asm volatile("" : "+s"(t)); return t; }
__device__ __forceinline__ int lnb() { int t = gridDim.x; asm volatile("" : "+s"(t)); return t; }
__device__ __forceinline__ float bf2f(bf16_t b) { return __uint_as_float(((unsigned)b) << 16); }
__device__ __forceinline__ bf16_t f2bf(float f) { unsigned u = __float_as_uint(f); u += 0x7fffu + ((u >> 16) & 1u); return (bf16_t)(u >> 16); }
__device__ __forceinline__ unsigned pack2(float lo, float hi) { return (unsigned)f2bf(lo) | ((unsigned)f2bf(hi) << 16); }
__device__ __forceinline__ float wave_sum(float v) {
#pragma unroll
    for (int o = 32; o >= 1; o >>= 1) v += __shfl_xor(v, o);
    return v;
}
__device__ __forceinline__ float sigmoidf_(float x) { return 1.0f / (1.0f + __expf(-x)); }
__device__ __forceinline__ float siluf_(float x) { return x / (1.0f + __expf(-x)); }
__device__ __forceinline__ float softplusf_(float x) { return fmaxf(x, 0.0f) + log1pf(__expf(-fabsf(x))); }
__device__ __forceinline__ float gelu_tanh_(float x) { const float u = 0.7978845608028654f * (x + 0.044715f * x * x * x); return 0.5f * x * (1.0f + tanhf(u)); }
__device__ __forceinline__ float row16_sum(float x) {
    x += __builtin_bit_cast(float, __builtin_amdgcn_update_dpp(0, __builtin_bit_cast(int, x), 0xB1, 0xF, 0xF, true));
    x += __builtin_bit_cast(float, __builtin_amdgcn_update_dpp(0, __builtin_bit_cast(int, x), 0x4E, 0xF, 0xF, true));
    x += __builtin_bit_cast(float, __builtin_amdgcn_update_dpp(0, __builtin_bit_cast(int, x), 0x141, 0xF, 0xF, true));
    x += __builtin_bit_cast(float, __builtin_amdgcn_update_dpp(0, __builtin_bit_cast(int, x), 0x140, 0xF, 0xF, true));
    return x;
}
namespace pg8 {
#define PG8_LAS __attribute__((address_space(3)))
typedef unsigned short bf16_t;
typedef short bf16x8 __attribute__((ext_vector_type(8)));
typedef float f32x4 __attribute__((ext_vector_type(4)));
typedef unsigned u32x4 __attribute__((ext_vector_type(4)));
constexpr int BM = 256, BK = 64, HALF = 128, HTB = HALF * BK * 2  , STAGE_BYTES = 8 * HTB, NXCD = 8, WGM = 8;

__host__ __device__ __forceinline__ int lds_byte(int r, int c) { const int st = (r >> 4) * 2 + (c >> 5), rr = r & 15, cc = c & 31, ob = rr * 64 + cc * 2; return st * 1024 + (ob ^ (((ob >> 9) & 1) << 5)); }
__host__ __device__ __forceinline__ void stage_rc(int b, int& R, int& C) { const int st = b / 1024, sb = b % 1024, swz = sb ^ (((sb >> 9) & 1) << 5); R = (st >> 1) * 16 + swz / 64; C = (st & 1) * 32 + (swz % 64) / 2; }
__host__ __device__ __forceinline__ int perm32(int rho) { const int n = rho >> 4, i = rho & 15; return 8 * (i >> 2) + 4 * n + (i & 3); }

struct Unit { int pm, pn; };
struct Gemm { const bf16_t* A; const bf16_t* Bt; int M, N, K; };

struct StaticOrder {
    int nM, nN, nwg, G, c;
    __host__ __device__ void init(int M, int N, int G_, int c_) { nM = M / BM; nN = N / BM; nwg = nM * nN; G = G_; c = c_; }
    __host__ __device__ bool next(int i, Unit& u) const {
        const long L = (long)i * G + c; if (L >= nwg) return false;
        int wgid = (int)L; { const int q = nwg / NXCD, r = nwg % NXCD, xcd = wgid % NXCD, off = wgid / NXCD; wgid = (xcd < r ? xcd * (q + 1) : r * (q + 1) + (xcd - r) * q) + off; }
        const int nig = WGM * nN, gid = wgid / nig, fm = gid * WGM, gsz = (nM - fm) < WGM ? (nM - fm) : WGM;
        u.pm = fm + ((wgid % nig) % gsz); u.pn = (wgid % nig) / gsz; return true;
    }
    __device__ __forceinline__ void a_ready(const Unit&) const {}
    __device__ __forceinline__ void done(const Unit&) const {}
};
__device__ __forceinline__ unsigned cvt_pk_bf16(float lo, float hi) { unsigned r; asm volatile("v_cvt_pk_bf16_f32 %0, %1, %2" : "=v"(r) : "v"(lo), "v"(hi)); return r; }
typedef float f32x2 __attribute__((ext_vector_type(2)));
template <class Epi, class Sched, bool STAMP = false>
__device__ __forceinline__ void gemm_phase(PG8_LAS unsigned char* lds, const Gemm g, const Sched& S, const Epi& E, unsigned long long* stamps) {
    const int tid = ltid(), wid = __builtin_amdgcn_readfirstlane(tid >> 6), lane = tid & 63, wr = wid >> 2, wc = wid & 3, fr = lane & 15, fq = lane >> 4;
    const int K = g.K, nt = K / BK;
    int ts_lo = 0, ts_hi = 0, nts = 0; const unsigned long long rt_entry = STAMP ? (unsigned long long)wall_clock64() : 0ull;
#define PG8_STAMP() do { if (STAMP && wid == 0 && nts < 64) { const unsigned long long _c = (unsigned long long)clock64(); \
        ts_lo = (lane == nts) ? (int)(unsigned)_c : ts_lo; ts_hi = (lane == nts) ? (int)(unsigned)(_c >> 32) : ts_hi; ++nts; } } while (0)
    PG8_STAMP();
    unsigned voffA[2], voffB[2];
#pragma unroll
    for (int i = 0; i < 2; ++i) { int R, C; stage_rc(tid * 16 + i * 8192, R, C); const int Rb = Epi::PERM ? ((R & ~31) + perm32(R & 31)) : R;
        voffA[i] = (unsigned)(R * K + C) * 2u; voffB[i] = (unsigned)(Rb * K + C) * 2u; }
    const size_t kstep = (size_t)(BK * 2);
    const size_t hstep = (size_t)HALF * K * 2;
    const size_t tstep = 2 * hstep;
    const unsigned ldsw = (unsigned)wid * 1024u;
    const int aoff = lds_byte(wr * 64 + fr, fq * 8), boff = lds_byte(wc * 32 + fr, fq * 8);
#define PG8_SA(b, h) (((b) * 2 + (h)) * HTB)
#define PG8_SB(b, h) ((4 + (b) * 2 + (h)) * HTB)
#define PG8_STAGE(bufoff, gbase, voff) do { _Pragma("unroll") for (int _i = 0; _i < 2; ++_i) \
        __builtin_amdgcn_global_load_lds((const unsigned*)((const char*)(gbase) + (voff)[_i]), (PG8_LAS unsigned*)(lds + (bufoff) + ldsw + _i * 8192), 16, 0, 0); } while (0)
#define PG8_LDA(dst, b, h) do { _Pragma("unroll") for (int m = 0; m < 4; ++m) _Pragma("unroll") for (int k = 0; k < 2; ++k) dst[m][k] = *(const PG8_LAS bf16x8*)(lds + PG8_SA(b, h) + aoff + m * 2048 + k * 1024); } while (0)
#define PG8_LDB(dst, b, h) do { _Pragma("unroll") for (int n = 0; n < 2; ++n) _Pragma("unroll") for (int k = 0; k < 2; ++k) dst[n][k] = *(const PG8_LAS bf16x8*)(lds + PG8_SB(b, h) + boff + n * 2048 + k * 1024); } while (0)
#define PG8_MMA(ai, bj, At, Bt) do { __builtin_amdgcn_s_setprio(1); _Pragma("unroll") for (int m = 0; m < 4; ++m) _Pragma("unroll") for (int n = 0; n < 2; ++n) _Pragma("unroll") for (int k = 0; k < 2; ++k) \
        acc[ai][bj][m][n] = __builtin_amdgcn_mfma_f32_16x16x32_bf16(Bt[n][k], At[m][k], acc[ai][bj][m][n], 0, 0, 0); __builtin_amdgcn_s_setprio(0); } while (0)
#define PG8_WAIT_V(n) asm volatile("s_waitcnt vmcnt(" #n ")" ::: "memory")
#define PG8_WAIT_L(n) asm volatile("s_waitcnt lgkmcnt(" #n ")" ::: "memory")
#define PG8_BAR __builtin_amdgcn_s_barrier()
#define PG8_SCHED __builtin_amdgcn_sched_barrier(0)
    Unit cur, nxt; int ui = 0;
    if (!S.next(0, cur)) return;
    f32x4 acc[2][2][4][2];
#pragma unroll
    for (int a = 0; a < 2; ++a)
#pragma unroll
        for (int b = 0; b < 2; ++b)
#pragma unroll
            for (int m = 0; m < 4; ++m)
#pragma unroll
                for (int n = 0; n < 2; ++n) acc[a][b][m][n] = (f32x4){0.f, 0.f, 0.f, 0.f};
    bf16x8 At[4][2], B0[2][2], B1[2][2];
    const char* cA = (const char*)g.A + (size_t)cur.pm * tstep; const char* cB = (const char*)g.Bt + (size_t)cur.pn * tstep;
    S.a_ready(cur);
    PG8_STAGE(PG8_SB(0, 0), cB, voffB); PG8_STAGE(PG8_SA(0, 0), cA, voffA); PG8_STAGE(PG8_SB(0, 1), cB + hstep, voffB); PG8_STAGE(PG8_SA(0, 1), cA + hstep, voffA);
    if (wr == 1) PG8_BAR;
    PG8_WAIT_V(4); PG8_BAR;
    PG8_STAGE(PG8_SB(1, 0), cB + kstep, voffB); PG8_STAGE(PG8_SA(1, 0), cA + kstep, voffA); PG8_STAGE(PG8_SB(1, 1), cB + hstep + kstep, voffB);
    PG8_WAIT_V(6); PG8_BAR;
    PG8_STAMP();
    for (;;) {
        const bool has_next = S.next(ui + 1, nxt);
        const char* nA = has_next ? (const char*)g.A + (size_t)nxt.pm * tstep : cA; const char* nB = has_next ? (const char*)g.Bt + (size_t)nxt.pn * tstep : cB;
        for (int t = 0; t < nt; t += 2) {
            const bool last = (t == nt - 2);
            const char* a1 = cA + (size_t)(t + 1) * kstep;
            const char* a2 = last ? nA : cA + (size_t)(t + 2) * kstep; const char* b2 = last ? nB : cB + (size_t)(t + 2) * kstep;
            const char* a3 = a2 + kstep; const char* b3 = b2 + kstep;
            if (last && has_next) S.a_ready(nxt);
            PG8_LDB(B0, 0, 0); PG8_SCHED; PG8_LDA(At, 0, 0); PG8_STAGE(PG8_SA(1, 1), a1 + hstep, voffA);
            PG8_WAIT_L(8); PG8_BAR; PG8_WAIT_L(0); PG8_MMA(0, 0, At, B0); PG8_BAR; PG8_SCHED;
            PG8_LDB(B1, 0, 1); PG8_STAGE(PG8_SB(0, 0), b2, voffB);
            PG8_BAR; PG8_WAIT_L(0); PG8_MMA(0, 1, At, B1); PG8_BAR;
            PG8_LDA(At, 0, 1); PG8_STAGE(PG8_SA(0, 0), a2, voffA);
            PG8_BAR; PG8_WAIT_L(0); PG8_MMA(1, 0, At, B0); PG8_BAR; PG8_SCHED;
            PG8_STAGE(PG8_SB(0, 1), b2 + hstep, voffB);
            PG8_WAIT_V(6); PG8_BAR; PG8_MMA(1, 1, At, B1); PG8_BAR;
            PG8_LDB(B0, 1, 0); PG8_SCHED; PG8_LDA(At, 1, 0); PG8_STAGE(PG8_SA(0, 1), a2 + hstep, voffA);
            PG8_WAIT_L(8); PG8_BAR; PG8_WAIT_L(0); PG8_MMA(0, 0, At, B0); PG8_BAR; PG8_SCHED;
            PG8_LDB(B1, 1, 1); PG8_STAGE(PG8_SB(1, 0), b3, voffB);
            PG8_BAR; PG8_WAIT_L(0); PG8_MMA(0, 1, At, B1); PG8_BAR;
            PG8_LDA(At, 1, 1); PG8_STAGE(PG8_SA(1, 0), a3, voffA);
            PG8_BAR; PG8_WAIT_L(0); PG8_MMA(1, 0, At, B0); PG8_BAR; PG8_SCHED;
            PG8_STAGE(PG8_SB(1, 1), b3 + hstep, voffB);
            PG8_WAIT_V(6); PG8_BAR; PG8_MMA(1, 1, At, B1); PG8_BAR;
        }
        PG8_STAMP();
        if constexpr (!Epi::AFTER_DRAIN) { E(acc, cur, wr, wc, fr, fq); S.done(cur); }
        PG8_STAMP();
        if (!has_next) break;
#pragma unroll
        for (int a = 0; a < 2; ++a)
#pragma unroll
            for (int b = 0; b < 2; ++b)
#pragma unroll
                for (int m = 0; m < 4; ++m)
#pragma unroll
                    for (int n = 0; n < 2; ++n) acc[a][b][m][n] = (f32x4){0.f, 0.f, 0.f, 0.f};
        cur = nxt; cA = nA; cB = nB; ++ui;
    }
    PG8_WAIT_V(0);
    if (wr == 0) PG8_BAR;
    PG8_BAR;
    if constexpr (Epi::AFTER_DRAIN) { E.fused(acc, cur, wr, wc, fr, fq, lds, wid, lane); S.done(cur); }
    PG8_STAMP();
    if (STAMP && wid == 0) { stamps[lane] = lane < nts ? (((unsigned long long)(unsigned)ts_hi << 32) | (unsigned)ts_lo) : 0ull;
        if (lane == 62) stamps[62] = rt_entry; if (lane == 63) stamps[63] = (unsigned long long)wall_clock64(); }
#undef PG8_STAMP
#undef PG8_SA
#undef PG8_SB
#undef PG8_STAGE
#undef PG8_LDA
#undef PG8_LDB
#undef PG8_MMA
#undef PG8_WAIT_V
#undef PG8_WAIT_L
#undef PG8_BAR
#undef PG8_SCHED
}
}

typedef unsigned u32x4_t __attribute__((ext_vector_type(4)));
typedef unsigned u32x2_t __attribute__((ext_vector_type(2)));
struct EpiP {
    static constexpr bool PERM = true, AFTER_DRAIN = false;
    bf16_t* O; bf16_t* bnd;
    __device__ __forceinline__ void operator()(const pg8::f32x4 (&acc)[2][2][4][2], const pg8::Unit& u, int wr, int wc, int fr, int fq) const {
        const int row0 = u.pm * 256 + wr * 64 + fr, col0 = u.pn * 256 + wc * 32 + 8 * fq;
#pragma unroll
        for (int ai = 0; ai < 2; ++ai)
#pragma unroll
            for (int m = 0; m < 4; ++m) { const int row = row0 + ai * 128 + m * 16; bf16_t* rowp = O + (size_t)row * PP + col0;
#pragma unroll
                for (int bj = 0; bj < 2; ++bj) { const pg8::f32x4 v0 = acc[ai][bj][m][0], v1 = acc[ai][bj][m][1];
                    u32x4_t w; w.x = pg8::cvt_pk_bf16(v0[0], v0[1]); w.y = pg8::cvt_pk_bf16(v0[2], v0[3]); w.z = pg8::cvt_pk_bf16(v1[0], v1[1]); w.w = pg8::cvt_pk_bf16(v1[2], v1[3]);
                    *(u32x4_t*)(rowp + bj * 128) = w;
                    if (bnd && (row & 127) >= 125) *(u32x4_t*)(bnd + ((size_t)(row >> 7) * 3 + (row & 127) - 125) * PP + col0 + bj * 128) = w; } }
    }
};
struct EpiRes {
    static constexpr bool PERM = false, AFTER_DRAIN = false;
    const float* base; float* out;
    __device__ __forceinline__ void operator()(const pg8::f32x4 (&acc)[2][2][4][2], const pg8::Unit& u, int wr, int wc, int fr, int fq) const {
        const int row0 = u.pm * 256 + wr * 64 + fr, col0 = u.pn * 256 + wc * 32 + 4 * fq;
#pragma unroll
        for (int ai = 0; ai < 2; ++ai)
#pragma unroll
            for (int m = 0; m < 4; ++m) { const size_t off = (size_t)(row0 + ai * 128 + m * 16) * DM + col0;
#pragma unroll
                for (int bj = 0; bj < 2; ++bj)
#pragma unroll
                    for (int n = 0; n < 2; ++n) { const size_t o = off + bj * 128 + n * 16; *(pg8::f32x4*)(out + o) = *(const pg8::f32x4*)(base + o) + acc[ai][bj][m][n]; } }
    }
};
struct EpiSwi {
    static constexpr bool PERM = true, AFTER_DRAIN = false;
    bf16_t* O;
    __device__ __forceinline__ void operator()(const pg8::f32x4 (&acc)[2][2][4][2], const pg8::Unit& u, int wr, int wc, int fr, int fq) const {
        const int row0 = u.pm * 256 + wr * 64 + fr, col0 = u.pn * 256 + wc * 32 + 8 * fq;
#pragma unroll
        for (int ai = 0; ai < 2; ++ai)
#pragma unroll
            for (int m = 0; m < 4; ++m) { bf16_t* rowp = O + (size_t)(row0 + ai * 128 + m * 16) * PP + (col0 >> 1);
#pragma unroll
                for (int bj = 0; bj < 2; ++bj) { const pg8::f32x4 g = acc[ai][bj][m][0], up = acc[ai][bj][m][1];
                    u32x2_t w; w.x = pg8::cvt_pk_bf16(siluf_(g[0]) * up[0], siluf_(g[1]) * up[1]); w.y = pg8::cvt_pk_bf16(siluf_(g[2]) * up[2], siluf_(g[3]) * up[3]);
                    *(u32x2_t*)(rowp + bj * 64) = w; } }
    }
};

struct ColSrc { const float* p; int ld; };
__device__ __forceinline__ ColSrc col_src(const Ctx& P, int layer, int mat, int r) {
    const int i = layer >> 1; const bool odd = layer & 1;
    ColSrc c; c.p = nullptr; c.ld = 0;
    if (mat == 0) { if (odd) { c.p = P.in[17] + (size_t)i * 1024 * 2816 + r; c.ld = 2816; } else if (r < 2316) { c.p = P.in[7] + (size_t)i * 1024 * 2316 + r; c.ld = 2316; } }
    else if (mat == 1) { c.p = (odd ? P.in[18] : P.in[8]) + (size_t)i * 1024 * 1024 + r; c.ld = 1024; }
    else if (mat == 2) { const int q = r >> 3, j = r & 7, f = 4 * q + (j & 3); c.p = (j < 4 ? P.in[3] : P.in[4]) + (size_t)layer * 1024 * 2816 + f; c.ld = 2816; }
    else { c.p = P.in[5] + (size_t)layer * 2816 * 1024 + r; c.ld = 1024; }
    return c;
}
__device__ void phase_convert(const Ctx& P, int layer, unsigned char* shm) {
    float* T = (float*)shm;
    const bool odd = layer & 1; const int n0 = (odd ? 44 : 40) * 16, n1 = 256, n2 = 88 * 16, n3 = 16 * 44, ntot = n0 + n1 + n2 + n3;
    const int tid = ltid();
    for (int tile = lbid(); tile < ntot; tile += lnb()) {
        int mat, rt, kt, K; bf16_t* dst;
        if (tile < n0) { mat = 0; K = 1024; rt = tile / 16; kt = tile % 16; dst = (bf16_t*)(P.ws + WS_WIN); }
        else if (tile < n0 + n1) { const int x = tile - n0; mat = 1; K = 1024; rt = x / 16; kt = x % 16; dst = (bf16_t*)(P.ws + WS_WOUT); }
        else if (tile < n0 + n1 + n2) { const int x = tile - n0 - n1; mat = 2; K = 1024; rt = x / 16; kt = x % 16; dst = (bf16_t*)(P.ws + WS_WGU); }
        else { const int x = tile - n0 - n1 - n2; mat = 3; K = 2816; rt = x / 44; kt = x % 44; dst = (bf16_t*)(P.ws + WS_WDN); }
        const int rr = tid & 63, kk = tid >> 6;
        const ColSrc cs = col_src(P, layer, mat, rt * 64 + rr);
#pragma unroll
        for (int k8 = 0; k8 < 8; ++k8) { const int k = k8 * 8 + kk; T[k * 65 + rr] = cs.p ? cs.p[(size_t)(kt * 64 + k) * cs.ld] : 0.f; }
        __syncthreads();
        const int r2 = tid >> 3, kq = tid & 7;
        uint4 w;
        w.x = pack2(T[(kq * 8 + 0) * 65 + r2], T[(kq * 8 + 1) * 65 + r2]); w.y = pack2(T[(kq * 8 + 2) * 65 + r2], T[(kq * 8 + 3) * 65 + r2]);
        w.z = pack2(T[(kq * 8 + 4) * 65 + r2], T[(kq * 8 + 5) * 65 + r2]); w.w = pack2(T[(kq * 8 + 6) * 65 + r2], T[(kq * 8 + 7) * 65 + r2]);
        *(uint4*)(dst + (size_t)(rt * 64 + r2) * K + kt * 64 + kq * 8) = w;
        __syncthreads();
    }
}

__device__ void phase_rmsnorm(const float* h, const float* g, bf16_t* out) {
    const int lane = ltid() & 63, gw = lbid() * 8 + (ltid() >> 6), nw = lnb() * 8;
    for (int row = gw; row < M_TOK; row += nw) {
        const float4* p = (const float4*)(h + (size_t)row * DM);
        float4 v[4]; float ss = 0.f;
#pragma unroll
        for (int i = 0; i < 4; ++i) { v[i] = p[lane + 64 * i]; ss += v[i].x * v[i].x + v[i].y * v[i].y + v[i].z * v[i].z + v[i].w * v[i].w; }
        ss = wave_sum(ss);
        const float rs = rsqrtf(ss * (1.0f / 1024.0f) + 1e-6f);
#pragma unroll
        for (int i = 0; i < 4; ++i) { const float4 g4 = ((const float4*)g)[lane + 64 * i]; uint2 w; w.x = pack2(v[i].x * rs * g4.x, v[i].y * rs * g4.y); w.y = pack2(v[i].z * rs * g4.z, v[i].w * rs * g4.w);
            *(uint2*)(out + (size_t)row * DM + (lane + 64 * i) * 4) = w; }
    }
}
__device__ void phase_final_norm(float* h, const float* g) {
    const int lane = ltid() & 63, gw = lbid() * 8 + (ltid() >> 6), nw = lnb() * 8;
    for (int row = gw; row < M_TOK; row += nw) {
        float4* p = (float4*)(h + (size_t)row * DM);
        float4 v[4]; float ss = 0.f;
#pragma unroll
        for (int i = 0; i < 4; ++i) { v[i] = p[lane + 64 * i]; ss += v[i].x * v[i].x + v[i].y * v[i].y + v[i].z * v[i].z + v[i].w * v[i].w; }
        ss = wave_sum(ss);
        const float rs = rsqrtf(ss * (1.0f / 1024.0f) + 1e-6f);
#pragma unroll
        for (int i = 0; i < 4; ++i) { const float4 g4 = ((const float4*)g)[lane + 64 * i]; float4 o; o.x = v[i].x * rs * g4.x; o.y = v[i].y * rs * g4.y; o.z = v[i].z * rs * g4.z; o.w = v[i].w * rs * g4.w; p[lane + 64 * i] = o; }
    }
}

__device__ __forceinline__ float* tokaux(bf16_t* Pb, int t) { return (float*)(Pb + (size_t)t * PP + 2560); }
__device__ __forceinline__ float bflo(unsigned w) { return __uint_as_float(w << 16); }
__device__ __forceinline__ float bfhi(unsigned w) { return __uint_as_float(w & 0xffff0000u); }

__device__ void phase_even_prep(const Ctx& P, int layer) {
    const int i = layer >> 1;
    bf16_t* Pb = (bf16_t*)(P.ws + WS_P);
    bf16_t* XBC = (bf16_t*)(P.ws + WS_SC + SC_XBC);
    float* PD = (float*)(P.ws + WS_SC + SC_PD);
    const float* cw = P.in[11] + (size_t)i * 4 * 1280; const float* cb = P.in[12] + i * 1280; const float* dtb = P.in[13] + i * 12;
    const int gt = lbid() * 512 + ltid(), gs = lnb() * 512;
    for (int idx = gt; idx < M_TOK * 160; idx += gs) {
        const int t = idx / 160, c8 = (idx % 160) * 8, tp = t & (SEQ - 1);
        float acc[8];
#pragma unroll
        for (int j = 0; j < 8; ++j) acc[j] = cb[c8 + j];
#pragma unroll
        for (int k = 0; k < 4; ++k) { const int back = 3 - k; if (tp - back < 0) continue;
            const uint4 raw = *(const uint4*)(Pb + (size_t)(t - back) * PP + 1024 + c8);
            const float* w = cw + k * 1280 + c8;
            acc[0] += w[0] * bflo(raw.x); acc[1] += w[1] * bfhi(raw.x); acc[2] += w[2] * bflo(raw.y); acc[3] += w[3] * bfhi(raw.y);
            acc[4] += w[4] * bflo(raw.z); acc[5] += w[5] * bfhi(raw.z); acc[6] += w[6] * bflo(raw.w); acc[7] += w[7] * bfhi(raw.w); }
        uint4 o; o.x = pack2(siluf_(acc[0]), siluf_(acc[1])); o.y = pack2(siluf_(acc[2]), siluf_(acc[3])); o.z = pack2(siluf_(acc[4]), siluf_(acc[5])); o.w = pack2(siluf_(acc[6]), siluf_(acc[7]));
        *(uint4*)(XBC + (size_t)t * 1280 + c8) = o;
    }
    for (int idx = gt; idx < M_TOK * 12; idx += gs) { const int t = idx / 12, e = idx % 12; tokaux(Pb, t)[e] = softplusf_(bf2f(Pb[(size_t)t * PP + 2304 + e]) + dtb[e]); }
    for (int idx = gt; idx < M_TOK * 32; idx += gs) {
        const int t = idx >> 5, c8 = (idx & 31) * 8, g = c8 >> 6, w = 2 << g, tp = t & (SEQ - 1), cnt = (tp + 1 < w) ? tp + 1 : w;
        float s[8], u[8];
#pragma unroll
        for (int j = 0; j < 8; ++j) { s[j] = 0.f; u[j] = 0.f; }
        for (int q = 0; q < cnt; ++q) { const uint4 raw = *(const uint4*)(Pb + (size_t)(t - q) * PP + c8);
            const float v0 = bflo(raw.x), v1 = bfhi(raw.x), v2 = bflo(raw.y), v3 = bfhi(raw.y), v4 = bflo(raw.z), v5 = bfhi(raw.z), v6 = bflo(raw.w), v7 = bfhi(raw.w);
            s[0] += v0; s[1] += v1; s[2] += v2; s[3] += v3; s[4] += v4; s[5] += v5; s[6] += v6; s[7] += v7;
            if (q == 0) { u[0] = v0; u[1] = v1; u[2] = v2; u[3] = v3; u[4] = v4; u[5] = v5; u[6] = v6; u[7] = v7; } }
        const float inv = 1.0f / (float)cnt;
        float4 d0, d1; d0.x = s[0] * inv - u[0]; d0.y = s[1] * inv - u[1]; d0.z = s[2] * inv - u[2]; d0.w = s[3] * inv - u[3]; d1.x = s[4] * inv - u[4]; d1.y = s[5] * inv - u[5]; d1.z = s[6] * inv - u[6]; d1.w = s[7] * inv - u[7];
        *(float4*)(PD + (size_t)t * 256 + c8) = d0; *(float4*)(PD + (size_t)t * 256 + c8 + 4) = d1;
    }
}

__device__ void phase_even_states(const Ctx& P, int layer, unsigned char* shm) {
    const int i = layer >> 1, tid = ltid();
    bf16_t* Pb = (bf16_t*)(P.ws + WS_P); bf16_t* YM = (bf16_t*)(P.ws + WS_HN);
    const bf16_t* XBC = (const bf16_t*)(P.ws + WS_SC + SC_XBC);
    const float* PD = (const float*)(P.ws + WS_SC + SC_PD);
    float* ST = (float*)(P.ws + WS_SC + SC_ST); float* CB = (float*)(P.ws + WS_SC + SC_CB); float* CDEC = (float*)(P.ws + WS_MISC + MS_CDEC);
    {
        float* T = (float*)shm;
        const float* pw = P.in[9] + (size_t)i * 4 * 64 * 64; const float* psc = P.in[10] + i * 256;
        const int col = tid & 255, half = tid >> 8, g = col >> 6, j = col & 63;
        float wreg[64];
#pragma unroll
        for (int c = 0; c < 64; ++c) wreg[c] = pw[(g * 64 + c) * 64 + j];
        const float sc = psc[col];
        for (int unit = lbid(); unit < 512; unit += lnb()) {
            const int t0 = unit * 64;
#pragma unroll
            for (int q = 0; q < 8; ++q) { const int i4 = q * 512 + tid; ((float4*)T)[i4] = ((const float4*)(PD + (size_t)t0 * 256))[i4]; }
            __syncthreads();
            for (int tt = 0; tt < 32; ++tt) { const int tok = half * 32 + tt; const float4* row = (const float4*)(T + tok * 256 + g * 64); float acc = 0.f;
#pragma unroll
                for (int c4 = 0; c4 < 16; ++c4) { const float4 d = row[c4]; acc += d.x * wreg[4 * c4] + d.y * wreg[4 * c4 + 1] + d.z * wreg[4 * c4 + 2] + d.w * wreg[4 * c4 + 3]; }
                YM[(size_t)(t0 + tok) * DM + col] = f2bf(acc * sc); }
            __syncthreads();
        }
    }
    {
        float* Bs = (float*)shm; float* Cs = Bs + 128 * 129; float* cum = Cs + 128 * 129; float* dts = cum + 768;
        const float* alog = P.in[14] + i * 12;
        for (int unit = lbid(); unit < 512; unit += lnb()) {
            const int b = unit >> 8, c = (unit >> 1) & 127, g = unit & 1, t0 = b * SEQ + c * 128;
            for (int idx = tid; idx < 128 * 16; idx += 512) { const int l = idx >> 4, n8 = (idx & 15) * 8;
                const uint4 rb = *(const uint4*)(XBC + (size_t)(t0 + l) * 1280 + 768 + g * 128 + n8), rc = *(const uint4*)(XBC + (size_t)(t0 + l) * 1280 + 1024 + g * 128 + n8);
                float* bp = Bs + l * 129 + n8; float* cp = Cs + l * 129 + n8;
                bp[0] = bflo(rb.x); bp[1] = bfhi(rb.x); bp[2] = bflo(rb.y); bp[3] = bfhi(rb.y); bp[4] = bflo(rb.z); bp[5] = bfhi(rb.z); bp[6] = bflo(rb.w); bp[7] = bfhi(rb.w);
                cp[0] = bflo(rc.x); cp[1] = bfhi(rc.x); cp[2] = bflo(rc.y); cp[3] = bfhi(rc.y); cp[4] = bflo(rc.z); cp[5] = bfhi(rc.z); cp[6] = bflo(rc.w); cp[7] = bfhi(rc.w); }
            if (tid < 6) { const int hh = g * 6 + tid; const float a = -__expf(alog[hh]); float cs = 0.f;
                for (int l = 0; l < 128; ++l) { float* ax = tokaux(Pb, t0 + l); const float dt = ax[hh]; cs += dt * a; cum[tid * 128 + l] = cs; dts[tid * 128 + l] = dt; ax[12 + hh] = cs; } }
            __syncthreads();
            { const int l = tid >> 2, sq = tid & 3; float accs[32];
#pragma unroll
              for (int q = 0; q < 32; ++q) accs[q] = 0.f;
              for (int n = 0; n < 128; ++n) { const float cv = Cs[l * 129 + n];
#pragma unroll
                  for (int q = 0; q < 32; ++q) accs[q] += cv * Bs[(sq + 4 * q) * 129 + n]; }
#pragma unroll
              for (int q = 0; q < 32; ++q) CB[(size_t)unit * 16384 + l * 128 + sq + 4 * q] = accs[q]; }
            __syncthreads();
            float* xs = Cs;
            for (int e = 0; e < 6; ++e) { const int hh = g * 6 + e; const float cl = cum[e * 128 + 127];
#pragma unroll
                for (int q = 0; q < 16; ++q) { const int idx = tid + 512 * q, l = idx >> 6, p = idx & 63;
                    xs[idx] = bf2f(XBC[(size_t)(t0 + l) * 1280 + hh * 64 + p]) * dts[e * 128 + l] * __expf(cl - cum[e * 128 + l]); }
                __syncthreads();
                { const int p = tid >> 3, nq = tid & 7; float a16[16];
#pragma unroll
                  for (int q = 0; q < 16; ++q) a16[q] = 0.f;
                  for (int l = 0; l < 128; ++l) { const float xv = xs[l * 64 + p];
#pragma unroll
                      for (int q = 0; q < 16; ++q) a16[q] += xv * Bs[l * 129 + nq + 8 * q]; }
                  float* so = ST + ((size_t)(b * 128 + c) * 12 + hh) * 8192 + p * 128 + nq;
#pragma unroll
                  for (int q = 0; q < 16; ++q) so[8 * q] = a16[q]; }
                if (tid == 0) CDEC[(b * 128 + c) * 12 + hh] = __expf(cl);
                __syncthreads();
            }
        }
    }
}

__device__ void phase_even_pass(const Ctx& P) {
    float* ST = (float*)(P.ws + WS_SC + SC_ST); const float* CDEC = (const float*)(P.ws + WS_MISC + MS_CDEC);
    for (int gt = lbid() * 512 + ltid(); gt < 98304; gt += lnb() * 512) {
        const int b = gt / 49152, rem = gt % 49152, hh = rem >> 12, i2 = rem & 4095;
        float2 h; h.x = 0.f; h.y = 0.f;
        for (int c0 = 0; c0 < 128; c0 += 8) {
            float2 st[8]; float dec[8];
#pragma unroll
            for (int q = 0; q < 8; ++q) { const size_t o = ((size_t)(b * 128 + c0 + q) * 12 + hh) * 8192 + i2 * 2; st[q] = *(const float2*)(ST + o); dec[q] = CDEC[(b * 128 + c0 + q) * 12 + hh]; }
#pragma unroll
            for (int q = 0; q < 8; ++q) { const size_t o = ((size_t)(b * 128 + c0 + q) * 12 + hh) * 8192 + i2 * 2; *(float2*)(ST + o) = h; h.x = h.x * dec[q] + st[q].x; h.y = h.y * dec[q] + st[q].y; }
        }
    }
}

__device__ void phase_even_out(const Ctx& P, int layer, unsigned char* shm) {
    const int i = layer >> 1, tid = ltid();
    bf16_t* Pb = (bf16_t*)(P.ws + WS_P); bf16_t* YM = (bf16_t*)(P.ws + WS_HN);
    const bf16_t* XBC = (const bf16_t*)(P.ws + WS_SC + SC_XBC);
    const float* ST = (const float*)(P.ws + WS_SC + SC_ST); const float* CB = (const float*)(P.ws + WS_SC + SC_CB);
    const float* dsk = P.in[15] + i * 12; const float* ng = P.in[16] + i * 768;
    float* Mx = (float*)shm; float* X = Mx + 128 * 129; float* cumL = X + 8256; float* dtL = cumL + 128;
    const int l = tid >> 2, p0 = (tid & 3) * 16;
    for (int unit = lbid(); unit < 512; unit += lnb()) {
        const int b = unit >> 8, c = (unit >> 1) & 127, g = unit & 1, t0 = b * SEQ + c * 128;
        float ssq = 0.f;
#pragma unroll 1
        for (int e = 0; e < 6; ++e) {
            const int hh = g * 6 + e;
            if (tid < 128) { const float* ax = tokaux(Pb, t0 + tid); cumL[tid] = ax[12 + hh]; dtL[tid] = ax[hh]; }
            __syncthreads();
#pragma unroll 4
            for (int q = 0; q < 32; ++q) { const int idx = tid + 512 * q, ll = idx >> 7, s = idx & 127;
                Mx[ll * 129 + s] = (s <= ll) ? CB[(size_t)unit * 16384 + idx] * __expf(fminf(cumL[ll] - cumL[s], 0.f)) * dtL[s] : 0.f; }
#pragma unroll 4
            for (int q = 0; q < 16; ++q) { const int idx = tid + 512 * q, s = idx >> 6, p = idx & 63; X[idx] = bf2f(XBC[(size_t)(t0 + s) * 1280 + hh * 64 + p]); }
            __syncthreads();
            float acc[16];
#pragma unroll
            for (int j = 0; j < 16; ++j) acc[j] = 0.f;
            for (int s = 0; s <= l; ++s) { const float m = Mx[l * 129 + s]; const float4* xr = (const float4*)(X + s * 64 + p0);
#pragma unroll
                for (int j4 = 0; j4 < 4; ++j4) { const float4 xv = xr[j4]; acc[4 * j4] += m * xv.x; acc[4 * j4 + 1] += m * xv.y; acc[4 * j4 + 2] += m * xv.z; acc[4 * j4 + 3] += m * xv.w; } }
            { const float dk = dsk[hh]; const float4* xr = (const float4*)(X + l * 64 + p0);
#pragma unroll
              for (int j4 = 0; j4 < 4; ++j4) { const float4 xv = xr[j4]; acc[4 * j4] += dk * xv.x; acc[4 * j4 + 1] += dk * xv.y; acc[4 * j4 + 2] += dk * xv.z; acc[4 * j4 + 3] += dk * xv.w; } }
            __syncthreads();
#pragma unroll 4
            for (int q = 0; q < 32; ++q) { const int idx = tid + 512 * q, ll = idx >> 7, n = idx & 127; Mx[ll * 129 + n] = bf2f(XBC[(size_t)(t0 + ll) * 1280 + 1024 + g * 128 + n]); }
#pragma unroll 4
            for (int q = 0; q < 16; ++q) { const int idx = tid + 512 * q, p = idx >> 7, n = idx & 127; X[p * 129 + n] = ST[((size_t)(b * 128 + c) * 12 + hh) * 8192 + idx]; }
            __syncthreads();
            float off[16];
#pragma unroll
            for (int j = 0; j < 16; ++j) off[j] = 0.f;
            for (int n = 0; n < 128; ++n) { const float cv = Mx[l * 129 + n];
#pragma unroll
                for (int j = 0; j < 16; ++j) off[j] += cv * X[(p0 + j) * 129 + n]; }
            const float el = __expf(cumL[l]);
            const bf16_t* zp = Pb + (size_t)(t0 + l) * PP + 256 + hh * 64 + p0;
            float yv[16];
#pragma unroll
            for (int j = 0; j < 16; ++j) { yv[j] = (acc[j] + el * off[j]) * siluf_(bf2f(zp[j])); ssq += yv[j] * yv[j]; }
            { bf16_t* yp = YM + (size_t)(t0 + l) * DM + 256 + g * 384 + e * 64 + p0; uint4 w0, w1;
              w0.x = pack2(yv[0], yv[1]); w0.y = pack2(yv[2], yv[3]); w0.z = pack2(yv[4], yv[5]); w0.w = pack2(yv[6], yv[7]);
              w1.x = pack2(yv[8], yv[9]); w1.y = pack2(yv[10], yv[11]); w1.z = pack2(yv[12], yv[13]); w1.w = pack2(yv[14], yv[15]);
              *(uint4*)yp = w0; *(uint4*)(yp + 8) = w1; }
            __syncthreads();
        }
        ssq += __shfl_xor(ssq, 1); ssq += __shfl_xor(ssq, 2);
        const float rstd = rsqrtf(ssq * (1.0f / 384.0f) + 1e-6f);
#pragma unroll 1
        for (int e = 0; e < 6; ++e) { const float* gp = ng + g * 384 + e * 64 + p0; bf16_t* yp = YM + (size_t)(t0 + l) * DM + 256 + g * 384 + e * 64 + p0;
            const uint4 r0 = *(const uint4*)yp, r1 = *(const uint4*)(yp + 8); uint4 w0, w1;
            w0.x = pack2(bflo(r0.x) * rstd * gp[0], bfhi(r0.x) * rstd * gp[1]); w0.y = pack2(bflo(r0.y) * rstd * gp[2], bfhi(r0.y) * rstd * gp[3]);
            w0.z = pack2(bflo(r0.z) * rstd * gp[4], bfhi(r0.z) * rstd * gp[5]); w0.w = pack2(bflo(r0.w) * rstd * gp[6], bfhi(r0.w) * rstd * gp[7]);
            w1.x = pack2(bflo(r1.x) * rstd * gp[8], bfhi(r1.x) * rstd * gp[9]); w1.y = pack2(bflo(r1.y) * rstd * gp[10], bfhi(r1.y) * rstd * gp[11]);
            w1.z = pack2(bflo(r1.z) * rstd * gp[12], bfhi(r1.z) * rstd * gp[13]); w1.w = pack2(bflo(r1.w) * rstd * gp[14], bfhi(r1.w) * rstd * gp[15]);
            *(uint4*)yp = w0; *(uint4*)(yp + 8) = w1; }
    }
}

__device__ void phase_odd_prep(const Ctx& P, int layer, unsigned char* shm) {
    const int i = layer >> 1, tid = ltid(), c = tid, lane = tid & 63, hd = tid >> 6;
    bf16_t* Pb = (bf16_t*)(P.ws + WS_P); bf16_t* YM = (bf16_t*)(P.ws + WS_HN);
    float* SCW = (float*)(P.ws + WS_SC + SC_W); bf16_t* SCKK = (bf16_t*)(P.ws + WS_SC + SC_KK); bf16_t* SCB = (bf16_t*)(P.ws + WS_SC + SC_B);
    const bf16_t* BND = (const bf16_t*)(P.ws + WS_MISC + MS_BND); float2* AGG = (float2*)(P.ws + WS_MISC + MS_AGG); float* BS = (float*)(P.ws + WS_MISC + MS_BS);
    float* ACT = (float*)shm; float* XC = ACT + 8 * 256;
    const float* mu = P.in[19] + i * 1792;
    const float mu_r = mu[c], mu_k = mu[512 + c], mu_v = mu[1024 + c];
    const float w0 = P.in[20][i * 512 + c], a0 = P.in[22][i * 512 + c], k_k = P.in[25][i * 512 + c], k_a = P.in[26][i * 512 + c], r_k = P.in[27][i * 512 + c];
    const float* w_up = P.in[21] + (size_t)i * 64 * 512; const float* a_up = P.in[23] + (size_t)i * 64 * 512; const float* g_up = P.in[24] + (size_t)i * 128 * 512;
    const float* lcw = P.in[30] + i * 4 * 512; const float cw0 = lcw[c], cw1 = lcw[512 + c], cw2 = lcw[1024 + c], cw3 = lcw[1536 + c], cbias = P.in[31][i * 512 + c];
    const float* wa = P.in[32] + (size_t)i * 8 * 64 * 64; const float* wx = P.in[34] + (size_t)i * 8 * 64 * 64;
    const float ba = P.in[33][i * 512 + c], bx = P.in[35][i * 512 + c];
    const float sp = softplusf_(-P.in[36][i * 512 + c]);
    const int jb = c >> 6, cc = c & 63;
    for (int tile = lbid(); tile < 256; tile += lnb()) {
        const int t0 = tile * 128; const bool first = (t0 & (SEQ - 1)) == 0;
        float pr = 0.f, pk = 0.f, pv = 0.f, x1 = 0.f, x2 = 0.f, x3 = 0.f;
        if (!first) { const bf16_t* b2 = BND + ((size_t)(tile - 1) * 3 + 2) * PP; pr = bf2f(b2[c]); pk = bf2f(b2[512 + c]); pv = bf2f(b2[1024 + c]);
            x1 = bf2f(b2[2304 + c]); x2 = bf2f((b2 - PP)[2304 + c]); x3 = bf2f((b2 - 2 * PP)[2304 + c]); }
        float sumlog = 0.f, hloc = 0.f;
        for (int bt = 0; bt < 16; ++bt) {
            const int tb = t0 + bt * 8;
#pragma unroll
            for (int q = 0; q < 4; ++q) { const int e = q * 512 + tid, tok = e >> 8, col = e & 255, t = tb + tok;
                const float raw = bf2f(Pb[(size_t)t * PP + 1536 + col]); const float prev = ((t & (SEQ - 1)) == 0) ? 0.f : bf2f(Pb[(size_t)(t - 1) * PP + 1536 + col]);
                const float s = raw + mu[1536 + col] * (prev - raw);
                ACT[e] = col < 64 ? tanhf(s) : (col < 128 ? s : sigmoidf_(s)); }
            float xcv[8];
#pragma unroll
            for (int tok = 0; tok < 8; ++tok) { const float xr = bf2f(Pb[(size_t)(tb + tok) * PP + 2304 + c]); const float xc = cbias + cw0 * x3 + cw1 * x2 + cw2 * x1 + cw3 * xr; x3 = x2; x2 = x1; x1 = xr; xcv[tok] = xc; XC[tok * 512 + c] = xc; }
            __syncthreads();
            float aw[8], aa[8], ag[8], arg[8], aig[8];
#pragma unroll
            for (int tok = 0; tok < 8; ++tok) { aw[tok] = 0.f; aa[tok] = 0.f; ag[tok] = 0.f; arg[tok] = 0.f; aig[tok] = 0.f; }
            for (int k = 0; k < 64; ++k) { const float wv = w_up[k * 512 + c], av = a_up[k * 512 + c];
#pragma unroll
                for (int tok = 0; tok < 8; ++tok) { aw[tok] += ACT[tok * 256 + k] * wv; aa[tok] += ACT[tok * 256 + 64 + k] * av; } }
            for (int k = 0; k < 128; ++k) { const float gv = g_up[k * 512 + c];
#pragma unroll
                for (int tok = 0; tok < 8; ++tok) ag[tok] += ACT[tok * 256 + 128 + k] * gv; }
            for (int ii = 0; ii < 64; ++ii) { const float wav = wa[(jb * 64 + ii) * 64 + cc], wxv = wx[(jb * 64 + ii) * 64 + cc];
#pragma unroll
                for (int tok = 0; tok < 8; ++tok) { const float xv = XC[tok * 512 + jb * 64 + ii]; arg[tok] += xv * wav; aig[tok] += xv * wxv; } }
#pragma unroll
            for (int tok = 0; tok < 8; ++tok) {
                const int t = tb + tok; bf16_t* prow = Pb + (size_t)t * PP;
                const float rr = bf2f(prow[c]), rk = bf2f(prow[512 + c]), rv = bf2f(prow[1024 + c]);
                const float rs = rr + mu_r * (pr - rr), ks = rk + mu_k * (pk - rk), vs = rv + mu_v * (pv - rv); pr = rr; pk = rk; pv = rv;
                const float wl = -softplusf_(-(w0 + aw[tok])) - 0.5f; const float wdec = __expf(-__expf(wl));
                const float a = sigmoidf_(a0 + aa[tok]);
                const float kk = ks * k_k; const float ss = wave_sum(kk * kk); const float kkn = kk * rsqrtf(ss + 1e-12f);
                const float k2 = ks * (1.0f + (a - 1.0f) * k_a), bq = kkn * a;
                const float bsum = wave_sum(rs * k2 * r_k); if (lane == 0) BS[t * 8 + hd] = bsum;
                prow[c] = f2bf(rs); prow[512 + c] = f2bf(k2); prow[1024 + c] = f2bf(vs);
                SCW[(size_t)t * 512 + c] = wdec; SCKK[(size_t)t * 512 + c] = f2bf(kkn); SCB[(size_t)t * 512 + c] = f2bf(bq); YM[(size_t)t * DM + c] = f2bf(ag[tok]);
                const float rg = sigmoidf_(arg[tok] + ba), ig = sigmoidf_(aig[tok] + bx); const float la = -8.0f * rg * sp; const bf16_t la_b = f2bf(la); const float la_r = bf2f(la_b);
                const float mult = sqrtf(fmaxf(-expm1f(2.0f * la), 0.f)); const float bl = mult * ig * xcv[tok]; const bf16_t bl_b = f2bf(bl);
                sumlog += la_r; hloc = __expf(la_r) * hloc + bf2f(bl_b);
                const float gtv = bf2f(prow[1792 + c]); YM[(size_t)t * DM + 512 + c] = f2bf(gelu_tanh_(gtv)); prow[1792 + c] = la_b; prow[2304 + c] = bl_b;
            }
            __syncthreads();
        }
        AGG[tile * 512 + c] = make_float2(sumlog, hloc);
    }
}

struct ScanStep { float4 w; uint2 kk, bb, kv, rv; float vv; };
__device__ void phase_odd_scan(const Ctx& P, unsigned char* shm) {
    const int tid = ltid(), wave = tid >> 6, lane = tid & 63;
    bf16_t* Pb = (bf16_t*)(P.ws + WS_P); bf16_t* YM = (bf16_t*)(P.ws + WS_HN);
    const float2* AGG = (const float2*)(P.ws + WS_MISC + MS_AGG);
    for (int task = lbid() * 8 + wave; task < 2048; task += lnb() * 8) {
        const int tile = task >> 3, c = (task & 7) * 64 + lane;
        float h = 0.f;
        for (int i = tile & ~127; i < tile; ++i) { const float2 ag = AGG[i * 512 + c]; h = __expf(ag.x) * h + ag.y; }
        for (int tb = 0; tb < 128; tb += 8) {
            float la[8], bl[8], gg[8];
#pragma unroll
            for (int q = 0; q < 8; ++q) { const size_t t = (size_t)tile * 128 + tb + q; la[q] = bf2f(Pb[t * PP + 1792 + c]); bl[q] = bf2f(Pb[t * PP + 2304 + c]); gg[q] = bf2f(YM[t * DM + 512 + c]); }
#pragma unroll
            for (int q = 0; q < 8; ++q) { const size_t t = (size_t)tile * 128 + tb + q; h = __expf(la[q]) * h + bl[q]; YM[t * DM + 512 + c] = f2bf(h * gg[q]); }
        }
    }
    if (wave == 0) {
        const float* __restrict__ SCW = (const float*)(P.ws + WS_SC + SC_W); const bf16_t* __restrict__ SCKK = (const bf16_t*)(P.ws + WS_SC + SC_KK); const bf16_t* __restrict__ SCB = (const bf16_t*)(P.ws + WS_SC + SC_B);
        float* SCY = (float*)(P.ws + WS_SC + SC_Y);
        for (int task = lbid(); task < 256; task += lnb()) {
            const int bh = task >> 4, b = bh >> 3, hd = bh & 7, v0 = (task & 15) * 4, q = lane >> 4, j = lane & 15;
            const size_t tokb = (size_t)b * SEQ;
            float s0 = 0.f, s1 = 0.f, s2 = 0.f, s3 = 0.f;
            ScanStep cur[4], nxt[4];
#define LOAD_STEPS(dst, tt) do { _Pragma("unroll") for (int u_ = 0; u_ < 4; ++u_) { const size_t tok_ = tokb + (tt) + u_; \
                dst[u_].w = *(const float4*)(SCW + tok_ * 512 + hd * 64 + 4 * j); dst[u_].kk = *(const uint2*)(SCKK + tok_ * 512 + hd * 64 + 4 * j); dst[u_].bb = *(const uint2*)(SCB + tok_ * 512 + hd * 64 + 4 * j); \
                dst[u_].kv = *(const uint2*)(Pb + tok_ * PP + 512 + hd * 64 + 4 * j); dst[u_].rv = *(const uint2*)(Pb + tok_ * PP + hd * 64 + 4 * j); dst[u_].vv = bf2f(Pb[tok_ * PP + 1024 + hd * 64 + v0 + q]); } } while (0)
            LOAD_STEPS(cur, 0);
            for (int t = 0; t < SEQ; t += 4) {
                const int tn = (t + 4 < SEQ) ? t + 4 : t;
                LOAD_STEPS(nxt, tn);
#pragma unroll
                for (int u = 0; u < 4; ++u) {
                    const ScanStep& z = cur[u];
                    float dot = s0 * bflo(z.kk.x) + s1 * bfhi(z.kk.x) + s2 * bflo(z.kk.y) + s3 * bfhi(z.kk.y);
                    dot = row16_sum(dot);
                    const float sa = -dot, vv = z.vv;
                    s0 = s0 * z.w.x + sa * bflo(z.bb.x) + vv * bflo(z.kv.x);
                    s1 = s1 * z.w.y + sa * bfhi(z.bb.x) + vv * bfhi(z.kv.x);
                    s2 = s2 * z.w.z + sa * bflo(z.bb.y) + vv * bflo(z.kv.y);
                    s3 = s3 * z.w.w + sa * bfhi(z.bb.y) + vv * bfhi(z.kv.y);
                    float yd = s0 * bflo(z.rv.x) + s1 * bfhi(z.rv.x) + s2 * bflo(z.rv.y) + s3 * bfhi(z.rv.y);
                    yd = row16_sum(yd);
                    if (j == 0) SCY[(tokb + t + u) * 512 + hd * 64 + v0 + q] = yd;
                }
#pragma unroll
                for (int u = 0; u < 4; ++u) cur[u] = nxt[u];
            }
#undef LOAD_STEPS
        }
    }
}

__device__ void phase_odd_post(const Ctx& P, int layer) {
    const int i = layer >> 1, lane = ltid() & 63;
    const bf16_t* Pb = (const bf16_t*)(P.ws + WS_P); bf16_t* YM = (bf16_t*)(P.ws + WS_HN);
    const float* SCY = (const float*)(P.ws + WS_SC + SC_Y); const float* BS = (const float*)(P.ws + WS_MISC + MS_BS);
    const float* lng = P.in[28] + i * 512; const float* lnbias = P.in[29] + i * 512;
    for (int task = lbid() * 8 + (ltid() >> 6); task < M_TOK * 8; task += lnb() * 8) {
        const int t = task >> 3, hd = task & 7, c = hd * 64 + lane;
        const float y = SCY[(size_t)t * 512 + c];
        const float mean = wave_sum(y) * (1.0f / 64.0f); const float d = y - mean; const float var = wave_sum(d * d) * (1.0f / 64.0f);
        const float yn = d * rsqrtf(var + 64e-5f) * lng[c] + lnbias[c];
        const float bonus = BS[t * 8 + hd] * bf2f(Pb[(size_t)t * PP + 1024 + c]);
        YM[(size_t)t * DM + c] = f2bf((yn + bonus) * bf2f(YM[(size_t)t * DM + c]));
    }
}

#ifndef SUBMASK
#define SUBMASK 0x3ff
#endif
#define EN(s) (((SUBMASK) >> (s)) & 1)
#ifndef PH_ODD_FORCE
#define PH_ODD_FORCE
#endif
constexpr int N_PHASES = 41;
__host__ __device__ inline bool phase_is_noop(int ph) { return ph < 40 && ((ph / 10) & 1) && (ph % 10) == 5; }

__device__ __forceinline__ void run_phase(const Ctx& P, int ph, unsigned char* shm) {
    bf16_t* HN = (bf16_t*)(P.ws + WS_HN); bf16_t* Pb = (bf16_t*)(P.ws + WS_P);
    if (ph == 40) { phase_final_norm(P.out, P.in[6]); return; }
    const int layer = ph / 10, sub = ph % 10; const bool odd = (layer & 1) PH_ODD_FORCE;
#ifdef ONLY_SUB
    if (sub != ONLY_SUB) return;
#endif

    switch (sub) {
    case 0: if (EN(0)) phase_convert(P, layer, shm); phase_rmsnorm(layer == 0 ? P.in[0] : P.out, P.in[1] + layer * DM, HN); break;
    case 1: if (EN(1)) { pg8::Gemm g{HN, (const bf16_t*)(P.ws + WS_WIN), M_TOK, odd ? 2816 : 2560, 1024}; pg8::StaticOrder S; S.init(g.M, g.N, lnb(), lbid());
              EpiP E{Pb, odd ? (bf16_t*)(P.ws + WS_MISC + MS_BND) : nullptr}; pg8::gemm_phase<EpiP, pg8::StaticOrder>((PG8_LAS unsigned char*)shm, g, S, E, nullptr); } break;
    case 2: if (EN(2)) if (odd) phase_odd_prep(P, layer, shm); else phase_even_prep(P, layer); break;
    case 3: if (EN(3)) if (odd) phase_odd_scan(P, shm); else phase_even_states(P, layer, shm); break;
    case 4: if (EN(4)) if (odd) phase_odd_post(P, layer); else phase_even_pass(P); break;
    case 5: if (EN(5)) if (!odd) phase_even_out(P, layer, shm); break;
    case 6: if (EN(6)) { pg8::Gemm g{HN, (const bf16_t*)(P.ws + WS_WOUT), M_TOK, 1024, 1024}; pg8::StaticOrder S; S.init(g.M, g.N, lnb(), lbid());
              EpiRes E{layer == 0 ? P.in[0] : P.out, P.out}; pg8::gemm_phase<EpiRes, pg8::StaticOrder>((PG8_LAS unsigned char*)shm, g, S, E, nullptr); } break;
    case 7: if (EN(7)) phase_rmsnorm(P.out, P.in[2] + layer * DM, HN); break;
    case 8: if (EN(8)) { pg8::Gemm g{HN, (const bf16_t*)(P.ws + WS_WGU), M_TOK, 5632, 1024}; pg8::StaticOrder S; S.init(g.M, g.N, lnb(), lbid());
              EpiSwi E{Pb}; pg8::gemm_phase<EpiSwi, pg8::StaticOrder>((PG8_LAS unsigned char*)shm, g, S, E, nullptr); } break;
    case 9: if (EN(9)) { pg8::Gemm g{Pb, (const bf16_t*)(P.ws + WS_WDN), M_TOK, 1024, 2816}; pg8::StaticOrder S; S.init(g.M, g.N, lnb(), lbid());
              EpiRes E{P.out, P.out}; pg8::gemm_phase<EpiRes, pg8::StaticOrder>((PG8_LAS unsigned char*)shm, g, S, E, nullptr); } break;
    }
}

__global__ void __launch_bounds__(512, 2) k_main(Params P) {
    extern __shared__ __attribute__((aligned(16))) unsigned char shm[];
    cg::grid_group grid = cg::this_grid();
    bool first = true;
    for (int ph = P.ph_lo; ph < P.ph_hi; ++ph) {
        if (phase_is_noop(ph)) continue;
        if (!first) grid.sync();
        first = false;
        int z = 0; asm volatile("" : "+s"(z));
        Ctx C; C.in.p = &P; C.in.z = z; C.out = P.out + z; C.ws = P.ws + z;
        run_phase(C, ph, shm);
    }
}

#ifndef MK_ONE_LAUNCH
#define MK_ONE_LAUNCH 0
#endif
extern "C" void kernel_launch(void* const* d_in, const int* in_sizes, int n_in, void* d_out, int out_size, void* d_ws, size_t ws_size, hipStream_t stream) {
    static int state = 0;
    if (state == 0) {
        if (n_in != NIN || out_size != M_TOK * DM || ws_size < WS_END) { fprintf(stderr, "kernel_launch: unexpected shapes (n_in %d out %d ws %zu)\n", n_in, out_size, ws_size); state = -1; return; }
        if (hipFuncSetAttribute((const void*)k_main, hipFuncAttributeMaxDynamicSharedMemorySize, LDS_BYTES) != hipSuccess) { fprintf(stderr, "kernel_launch: hipFuncSetAttribute failed\n"); state = -1; return; }
        state = 1;
    }
    if (state < 0) return;
    Params p{};
    for (int i = 0; i < NIN; ++i) p.in[i] = (const float*)d_in[i];
    p.out = (float*)d_out; p.ws = (unsigned char*)d_ws;
#if MK_ONE_LAUNCH
    p.ph_lo = 0; p.ph_hi = N_PHASES;
    void* args[] = {&p};
    hipError_t e = hipLaunchCooperativeKernel((const void*)k_main, dim3(256), dim3(512), args, LDS_BYTES, stream);
    if (e != hipSuccess) fprintf(stderr, "cooperative launch failed: %s\n", hipGetErrorString(e));
#else
    for (int ph = 0; ph < N_PHASES; ++ph) { if (phase_is_noop(ph)) continue; p.ph_lo = ph; p.ph_hi = ph + 1; hipLaunchKernelGGL(k_main, dim3(256), dim3(512), LDS_BYTES, stream, p); }
#endif
}
```

```cpp
#include <hip/hip_runtime.h>
#include <hip/hip_cooperative_groups.h>
#include <cstdio>
namespace cg = cooperative_groups;

typedef unsigned short bf16_t;
constexpr int M_TOK = 32768, SEQ = 16384, DM = 1024, FF = 2816, PP = 2816;
constexpr int LDS_BYTES = 163840;
constexpr int NIN = 37;

constexpr size_t MiB = 1048576;
constexpr size_t WS_WIN = 0, WS_WOUT = 5767168, WS_WGU = 7864320, WS_WDN = 19398656;
constexpr size_t WS_HN = 24 * MiB, WS_P = 88 * MiB, WS_SC = 264 * MiB, WS_MISC = 504 * MiB, WS_END = 512 * MiB;
constexpr size_t SC_XBC = 0, SC_ST = 80 * MiB, SC_CB = 176 * MiB, SC_PD = 208 * MiB;
constexpr size_t SC_W = 0, SC_KK = 64 * MiB, SC_B = 96 * MiB, SC_Y = 128 * MiB;
constexpr size_t MS_BND = 0, MS_AGG = 4325376, MS_BS = MS_AGG + 1048576, MS_CDEC = MS_BS + 1048576, MS_BAR = MS_CDEC + 12288, BAR_BYTES = 3456 * 4, MS_SS1 = MS_BAR + BAR_BYTES, MS_SS2 = MS_SS1 + 131072;
constexpr size_t SC_HB2 = 0, SC_SSP2 = 64 * MiB, SC_SSP1 = 66 * MiB;
__device__ __forceinline__ float row_rstd(const float* ssp, int row) { const float4* p = (const float4*)(ssp + (size_t)row * 16); const float4 a = p[0], b = p[1], c = p[2], d = p[3];
    const float s = ((a.x + a.y) + (a.z + a.w)) + ((b.x + b.y) + (b.z + b.w)) + ((c.x + c.y) + (c.z + c.w)) + ((d.x + d.y) + (d.z + d.w)); return rsqrtf(s * (1.0f / 1024.0f) + 1e-6f); }
constexpr size_t SC_UNUSED_ = 0;

#define LAS __attribute__((address_space(3)))
struct Params { const float* in[NIN]; float* out; unsigned char* ws; int ph_lo, ph_hi; };
struct InArr { const Params* p; int z; __device__ __forceinline__ const float* operator[](int k) const { return p->in[k + z]; } };
struct Ctx { InArr in; float* out; unsigned char* ws; };

__device__ __forceinline__ int ltid() { int t = threadIdx.x; asm volatile("" : "+v"(t)); return t; }
__device__ __forceinline__ int lbid() { int t = blockIdx.x; asm volatile("" : "+s"(t)); return t; }
__device__ __forceinline__ int lnb() { int t = gridDim.x; asm volatile("" : "+s"(t)); return t; }
__device__ __forceinline__ float bf2f(bf16_t b) { return __uint_as_float(((unsigned)b) << 16); }
typedef __bf16 bf16x2_nat __attribute__((ext_vector_type(2)));
__device__ __forceinline__ unsigned pack2(float lo, float hi) { bf16x2_nat v; v.x = (__bf16)lo; v.y = (__bf16)hi; return __builtin_bit_cast(unsigned, v); }
__device__ __forceinline__ bf16_t f2bf(float f) { return __builtin_bit_cast(bf16_t, (__bf16)f); }
__device__ __forceinline__ float wave_sum(float v) {
#pragma unroll
    for (int o = 32; o >= 1; o >>= 1) v += __shfl_xor(v, o);
    return v;
}
__device__ __forceinline__ float rcpf_(float x) { return __builtin_amdgcn_rcpf(x); }
__device__ __forceinline__ float sigmoidf_(float x) { return rcpf_(1.0f + __expf(-x)); }
__device__ __forceinline__ float siluf_(float x) { return x * rcpf_(1.0f + __expf(-x)); }
__device__ __forceinline__ float softplusf_(float x) { return fmaxf(x, 0.0f) + __logf(1.0f + __expf(-fabsf(x))); }
__device__ __forceinline__ float tanhf_(float x) { return 1.0f - 2.0f * rcpf_(1.0f + __expf(2.0f * x)); }
__device__ __forceinline__ float gelu_tanh_(float x) { const float u = 0.7978845608028654f * (x + 0.044715f * x * x * x); return 0.5f * x * (1.0f + tanhf_(u)); }
__device__ __forceinline__ float row16_sum(float x) {
    x += __builtin_bit_cast(float, __builtin_amdgcn_update_dpp(0, __builtin_bit_cast(int, x), 0xB1, 0xF, 0xF, true));
    x += __builtin_bit_cast(float, __builtin_amdgcn_update_dpp(0, __builtin_bit_cast(int, x), 0x4E, 0xF, 0xF, true));
    x += __builtin_bit_cast(float, __builtin_amdgcn_update_dpp(0, __builtin_bit_cast(int, x), 0x141, 0xF, 0xF, true));
    x += __builtin_bit_cast(float, __builtin_amdgcn_update_dpp(0, __builtin_bit_cast(int, x), 0x140, 0xF, 0xF, true));
    return x;
}
__device__ __forceinline__ float bflo(unsigned w) { return __uint_as_float(w << 16); }
__device__ __forceinline__ float bfhi(unsigned w) { return __uint_as_float(w & 0xffff0000u); }
typedef short bf16x8_t __attribute__((ext_vector_type(8)));
typedef float f32x16_t __attribute__((ext_vector_type(16)));
__device__ __forceinline__ uint4 pack8(const float* v) { uint4 o; o.x = pack2(v[0], v[1]); o.y = pack2(v[2], v[3]); o.z = pack2(v[4], v[5]); o.w = pack2(v[6], v[7]); return o; }
__device__ __forceinline__ void unpack8(const uint4 r, float* v) { v[0] = bflo(r.x); v[1] = bfhi(r.x); v[2] = bflo(r.y); v[3] = bfhi(r.y); v[4] = bflo(r.z); v[5] = bfhi(r.z); v[6] = bflo(r.w); v[7] = bfhi(r.w); }
__device__ __forceinline__ float half32_sum(float x) { x = row16_sum(x); return x + __shfl_xor(x, 16); }

namespace pg8 {
#define PG8_LAS __attribute__((address_space(3)))
typedef unsigned short bf16_t;
typedef short bf16x8 __attribute__((ext_vector_type(8)));
typedef float f32x4 __attribute__((ext_vector_type(4)));
typedef unsigned u32x4 __attribute__((ext_vector_type(4)));
constexpr int BM = 256, BK = 64, HALF = 128, HTB = HALF * BK * 2  , STAGE_BYTES = 8 * HTB, NXCD = 8, WGM = 8;

__host__ __device__ __forceinline__ int lds_byte(int r, int c) { const int st = (r >> 4) * 2 + (c >> 5), rr = r & 15, cc = c & 31, ob = rr * 64 + cc * 2; return st * 1024 + (ob ^ (((ob >> 9) & 1) << 5)); }
__host__ __device__ __forceinline__ void stage_rc(int b, int& R, int& C) { const int st = b / 1024, sb = b % 1024, swz = sb ^ (((sb >> 9) & 1) << 5); R = (st >> 1) * 16 + swz / 64; C = (st & 1) * 32 + (swz % 64) / 2; }
__host__ __device__ __forceinline__ int perm32(int rho) { const int n = rho >> 4, i = rho & 15; return 8 * (i >> 2) + 4 * n + (i & 3); }

struct Unit { int pm, pn; };
struct Gemm { const bf16_t* A; const bf16_t* Bt; int M, N, K; };

struct StaticOrder {
    int nM, nN, nwg, G, c;
    __host__ __device__ void init(int M, int N, int G_, int c_) { nM = M / BM; nN = N / BM; nwg = nM * nN; G = G_; c = c_; }
    __host__ __device__ bool next(int i, Unit& u) const {
        const long L = (long)i * G + c; if (L >= nwg) return false;
        int wgid = (int)L; { const int q = nwg / NXCD, r = nwg % NXCD, xcd = wgid % NXCD, off = wgid / NXCD; wgid = (xcd < r ? xcd * (q + 1) : r * (q + 1) + (xcd - r) * q) + off; }
        const int nig = WGM * nN, gid = wgid / nig, fm = gid * WGM, gsz = (nM - fm) < WGM ? (nM - fm) : WGM;
        u.pm = fm + ((wgid % nig) % gsz); u.pn = (wgid % nig) / gsz; return true;
    }
    __device__ __forceinline__ void a_ready(const Unit&) const {}
    __device__ __forceinline__ void done(const Unit&) const {}
};
__device__ __forceinline__ unsigned cvt_pk_bf16(float lo, float hi) { unsigned r; asm volatile("v_cvt_pk_bf16_f32 %0, %1, %2" : "=v"(r) : "v"(lo), "v"(hi)); return r; }
typedef float f32x2 __attribute__((ext_vector_type(2)));
template <class Epi, class Sched, bool STAMP = false>
__device__ __forceinline__ void gemm_phase(PG8_LAS unsigned char* lds, const Gemm g, const Sched& S, const Epi& E, unsigned long long* stamps) {
    const int tid = ltid(), wid = __builtin_amdgcn_readfirstlane(tid >> 6), lane = tid & 63, wr = wid >> 2, wc = wid & 3, fr = lane & 15, fq = lane >> 4;
    const int K = g.K, nt = K / BK;
    int ts_lo = 0, ts_hi = 0, nts = 0; const unsigned long long rt_entry = STAMP ? (unsigned long long)wall_clock64() : 0ull;
#define PG8_STAMP() do { if (STAMP && wid == 0 && nts < 64) { const unsigned long long _c = (unsigned long long)clock64(); \
        ts_lo = (lane == nts) ? (int)(unsigned)_c : ts_lo; ts_hi = (lane == nts) ? (int)(unsigned)(_c >> 32) : ts_hi; ++nts; } } while (0)
    PG8_STAMP();
    unsigned voffA[2], voffB[2];
#pragma unroll
    for (int i = 0; i < 2; ++i) { int R, C; stage_rc(tid * 16 + i * 8192, R, C); const int Rb = Epi::PERM ? ((R & ~31) + perm32(R & 31)) : R;
        voffA[i] = (unsigned)(R * K + C) * 2u; voffB[i] = (unsigned)(Rb * K + C) * 2u; }
    const size_t kstep = (size_t)(BK * 2);
    const size_t hstep = (size_t)HALF * K * 2;
    const size_t tstep = 2 * hstep;
    const unsigned ldsw = (unsigned)wid * 1024u;
    const int aoff = lds_byte(wr * 64 + fr, fq * 8), boff = lds_byte(wc * 32 + fr, fq * 8);
#define PG8_SA(b, h) (((b) * 2 + (h)) * HTB)
#define PG8_SB(b, h) ((4 + (b) * 2 + (h)) * HTB)
#define PG8_STAGE(bufoff, gbase, voff) do { _Pragma("unroll") for (int _i = 0; _i < 2; ++_i) \
        __builtin_amdgcn_global_load_lds((const unsigned*)((const char*)(gbase) + (voff)[_i]), (PG8_LAS unsigned*)(lds + (bufoff) + ldsw + _i * 8192), 16, 0, 0); } while (0)
#define PG8_LDA(dst, b, h) do { _Pragma("unroll") for (int m = 0; m < 4; ++m) _Pragma("unroll") for (int k = 0; k < 2; ++k) dst[m][k] = *(const PG8_LAS bf16x8*)(lds + PG8_SA(b, h) + aoff + m * 2048 + k * 1024); } while (0)
#define PG8_LDB(dst, b, h) do { _Pragma("unroll") for (int n = 0; n < 2; ++n) _Pragma("unroll") for (int k = 0; k < 2; ++k) dst[n][k] = *(const PG8_LAS bf16x8*)(lds + PG8_SB(b, h) + boff + n * 2048 + k * 1024); } while (0)
#define PG8_MMA(ai, bj, At, Bt) do { __builtin_amdgcn_s_setprio(1); _Pragma("unroll") for (int m = 0; m < 4; ++m) _Pragma("unroll") for (int n = 0; n < 2; ++n) _Pragma("unroll") for (int k = 0; k < 2; ++k) \
        acc[ai][bj][m][n] = __builtin_amdgcn_mfma_f32_16x16x32_bf16(Bt[n][k], At[m][k], acc[ai][bj][m][n], 0, 0, 0); __builtin_amdgcn_s_setprio(0); } while (0)
#define PG8_WAIT_V(n) asm volatile("s_waitcnt vmcnt(" #n ")" ::: "memory")
#define PG8_WAIT_L(n) asm volatile("s_waitcnt lgkmcnt(" #n ")" ::: "memory")
#define PG8_BAR __builtin_amdgcn_s_barrier()
#define PG8_SCHED __builtin_amdgcn_sched_barrier(0)
    Unit cur, nxt; int ui = 0;
    if (!S.next(0, cur)) return;
    f32x4 acc[2][2][4][2];
#pragma unroll
    for (int a = 0; a < 2; ++a)
#pragma unroll
        for (int b = 0; b < 2; ++b)
#pragma unroll
            for (int m = 0; m < 4; ++m)
#pragma unroll
                for (int n = 0; n < 2; ++n) acc[a][b][m][n] = (f32x4){0.f, 0.f, 0.f, 0.f};
    bf16x8 At[4][2], B0[2][2], B1[2][2];
    const char* cA = (const char*)g.A + (size_t)cur.pm * tstep; const char* cB = (const char*)g.Bt + (size_t)cur.pn * tstep;
    S.a_ready(cur);
    PG8_STAGE(PG8_SB(0, 0), cB, voffB); PG8_STAGE(PG8_SA(0, 0), cA, voffA); PG8_STAGE(PG8_SB(0, 1), cB + hstep, voffB); PG8_STAGE(PG8_SA(0, 1), cA + hstep, voffA);
    if (wr == 1) PG8_BAR;
    PG8_WAIT_V(4); PG8_BAR;
    PG8_STAGE(PG8_SB(1, 0), cB + kstep, voffB); PG8_STAGE(PG8_SA(1, 0), cA + kstep, voffA); PG8_STAGE(PG8_SB(1, 1), cB + hstep + kstep, voffB);
    PG8_WAIT_V(6); PG8_BAR;
    PG8_STAMP();
    for (;;) {
        const bool has_next = S.next(ui + 1, nxt);
        const char* nA = has_next ? (const char*)g.A + (size_t)nxt.pm * tstep : cA; const char* nB = has_next ? (const char*)g.Bt + (size_t)nxt.pn * tstep : cB;
        for (int t = 0; t < nt; t += 2) {
            const bool last = (t == nt - 2);
            const char* a1 = cA + (size_t)(t + 1) * kstep;
            const char* a2 = last ? nA : cA + (size_t)(t + 2) * kstep; const char* b2 = last ? nB : cB + (size_t)(t + 2) * kstep;
            const char* a3 = a2 + kstep; const char* b3 = b2 + kstep;
            if (last && has_next) S.a_ready(nxt);
            PG8_LDB(B0, 0, 0); PG8_SCHED; PG8_LDA(At, 0, 0); PG8_STAGE(PG8_SA(1, 1), a1 + hstep, voffA);
            PG8_WAIT_L(8); PG8_BAR; PG8_WAIT_L(0); PG8_MMA(0, 0, At, B0); PG8_BAR; PG8_SCHED;
            PG8_LDB(B1, 0, 1); PG8_STAGE(PG8_SB(0, 0), b2, voffB);
            PG8_BAR; PG8_WAIT_L(0); PG8_MMA(0, 1, At, B1); PG8_BAR;
            PG8_LDA(At, 0, 1); PG8_STAGE(PG8_SA(0, 0), a2, voffA);
            PG8_BAR; PG8_WAIT_L(0); PG8_MMA(1, 0, At, B0); PG8_BAR; PG8_SCHED;
            PG8_STAGE(PG8_SB(0, 1), b2 + hstep, voffB);
            PG8_WAIT_V(6); PG8_BAR; PG8_MMA(1, 1, At, B1); PG8_BAR;
            PG8_LDB(B0, 1, 0); PG8_SCHED; PG8_LDA(At, 1, 0); PG8_STAGE(PG8_SA(0, 1), a2 + hstep, voffA);
            PG8_WAIT_L(8); PG8_BAR; PG8_WAIT_L(0); PG8_MMA(0, 0, At, B0); PG8_BAR; PG8_SCHED;
            PG8_LDB(B1, 1, 1); PG8_STAGE(PG8_SB(1, 0), b3, voffB);
            PG8_BAR; PG8_WAIT_L(0); PG8_MMA(0, 1, At, B1); PG8_BAR;
            PG8_LDA(At, 1, 1); PG8_STAGE(PG8_SA(1, 0), a3, voffA);
            PG8_BAR; PG8_WAIT_L(0); PG8_MMA(1, 0, At, B0); PG8_BAR; PG8_SCHED;
            PG8_STAGE(PG8_SB(1, 1), b3 + hstep, voffB);
            PG8_WAIT_V(6); PG8_BAR; PG8_MMA(1, 1, At, B1); PG8_BAR;
        }
        PG8_STAMP();
        if constexpr (!Epi::AFTER_DRAIN) { E(acc, cur, wr, wc, fr, fq); S.done(cur); }
        PG8_STAMP();
        if (!has_next) break;
#pragma unroll
        for (int a = 0; a < 2; ++a)
#pragma unroll
            for (int b = 0; b < 2; ++b)
#pragma unroll
                for (int m = 0; m < 4; ++m)
#pragma unroll
                    for (int n = 0; n < 2; ++n) acc[a][b][m][n] = (f32x4){0.f, 0.f, 0.f, 0.f};
        cur = nxt; cA = nA; cB = nB; ++ui;
    }
    PG8_WAIT_V(0);
    if (wr == 0) PG8_BAR;
    PG8_BAR;
    if constexpr (Epi::AFTER_DRAIN) { E.fused(acc, cur, wr, wc, fr, fq, lds, wid, lane); S.done(cur); }
    PG8_STAMP();
    if (STAMP && wid == 0) { stamps[lane] = lane < nts ? (((unsigned long long)(unsigned)ts_hi << 32) | (unsigned)ts_lo) : 0ull;
        if (lane == 62) stamps[62] = rt_entry; if (lane == 63) stamps[63] = (unsigned long long)wall_clock64(); }
#undef PG8_STAMP
#undef PG8_SA
#undef PG8_SB
#undef PG8_STAGE
#undef PG8_LDA
#undef PG8_LDB
#undef PG8_MMA
#undef PG8_WAIT_V
#undef PG8_WAIT_L
#undef PG8_BAR
#undef PG8_SCHED
}
}

typedef unsigned u32x4_t __attribute__((ext_vector_type(4)));
typedef unsigned u32x2_t __attribute__((ext_vector_type(2)));
struct EpiP {
    static constexpr bool PERM = true, AFTER_DRAIN = false;
    bf16_t* O; bf16_t* bnd; const float* ss;
    __device__ __forceinline__ void operator()(const pg8::f32x4 (&acc)[2][2][4][2], const pg8::Unit& u, int wr, int wc, int fr, int fq) const {
        const int row0 = u.pm * 256 + wr * 64 + fr, col0 = u.pn * 256 + wc * 32 + 8 * fq;
        float rsv[2][4];
#pragma unroll
        for (int ai = 0; ai < 2; ++ai)
#pragma unroll
            for (int m = 0; m < 4; ++m) rsv[ai][m] = ss[row0 + ai * 128 + m * 16];
#pragma unroll
        for (int ai = 0; ai < 2; ++ai)
#pragma unroll
            for (int m = 0; m < 4; ++m) { const int row = row0 + ai * 128 + m * 16; bf16_t* rowp = O + (size_t)row * PP + col0; const float rs = rsv[ai][m];
#pragma unroll
                for (int bj = 0; bj < 2; ++bj) { const pg8::f32x4 v0 = acc[ai][bj][m][0] * rs, v1 = acc[ai][bj][m][1] * rs;
                    u32x4_t w; w.x = pack2(v0[0], v0[1]); w.y = pack2(v0[2], v0[3]); w.z = pack2(v1[0], v1[1]); w.w = pack2(v1[2], v1[3]);
                    *(u32x4_t*)(rowp + bj * 128) = w;
                    if (bnd && (row & 127) >= 125) *(u32x4_t*)(bnd + ((size_t)(row >> 7) * 3 + (row & 127) - 125) * PP + col0 + bj * 128) = w; } }
    }
};
struct EpiRes {
    static constexpr bool PERM = true, AFTER_DRAIN = false;
    const bf16_t* hin; bf16_t* hout; float* ss;
    __device__ __forceinline__ void operator()(const pg8::f32x4 (&acc)[2][2][4][2], const pg8::Unit& u, int wr, int wc, int fr, int fq) const {
        const int row0 = u.pm * 256 + wr * 64 + fr, col0 = u.pn * 256 + wc * 32 + 8 * fq;
#pragma unroll
        for (int ai = 0; ai < 2; ++ai) {
            u32x4_t bv[4][2];
#pragma unroll
            for (int m = 0; m < 4; ++m)
#pragma unroll
                for (int bj = 0; bj < 2; ++bj) bv[m][bj] = *(const u32x4_t*)(hin + (size_t)(row0 + ai * 128 + m * 16) * DM + col0 + bj * 128);
#pragma unroll
            for (int m = 0; m < 4; ++m) { const int row = row0 + ai * 128 + m * 16; float sq = 0.f;
#pragma unroll
                for (int bj = 0; bj < 2; ++bj) { const u32x4_t r = bv[m][bj]; const pg8::f32x4 a0 = acc[ai][bj][m][0], a1 = acc[ai][bj][m][1];
                    const float v0 = bflo(r.x) + a0[0], v1 = bfhi(r.x) + a0[1], v2 = bflo(r.y) + a0[2], v3 = bfhi(r.y) + a0[3], v4 = bflo(r.z) + a1[0], v5 = bfhi(r.z) + a1[1], v6 = bflo(r.w) + a1[2], v7 = bfhi(r.w) + a1[3];
                    u32x4_t w; w.x = pack2(v0, v1); w.y = pack2(v2, v3); w.z = pack2(v4, v5); w.w = pack2(v6, v7);
                    *(u32x4_t*)(hout + (size_t)row * DM + col0 + bj * 128) = w;
                    sq += (v0 * v0 + v1 * v1) + (v2 * v2 + v3 * v3) + (v4 * v4 + v5 * v5) + (v6 * v6 + v7 * v7); }
                sq += __shfl_xor(sq, 16); sq += __shfl_xor(sq, 32);
                if (fq == 0) ss[(size_t)row * 16 + u.pn * 4 + wc] = sq; }
            asm volatile("" ::: "memory"); }
    }
};
struct EpiSwi {
    static constexpr bool PERM = true, AFTER_DRAIN = false;
    bf16_t* O; const float* ss;
    __device__ __forceinline__ void operator()(const pg8::f32x4 (&acc)[2][2][4][2], const pg8::Unit& u, int wr, int wc, int fr, int fq) const {
        const int row0 = u.pm * 256 + wr * 64 + fr, col0 = u.pn * 256 + wc * 32 + 8 * fq;
        float rsv[2][4];
#pragma unroll
        for (int ai = 0; ai < 2; ++ai)
#pragma unroll
            for (int m = 0; m < 4; ++m) rsv[ai][m] = ss[row0 + ai * 128 + m * 16];
#pragma unroll
        for (int ai = 0; ai < 2; ++ai)
#pragma unroll
            for (int m = 0; m < 4; ++m) { const int row = row0 + ai * 128 + m * 16; bf16_t* rowp = O + (size_t)row * PP + (col0 >> 1); const float rs = rsv[ai][m];
#pragma unroll
                for (int bj = 0; bj < 2; ++bj) { const pg8::f32x4 g = acc[ai][bj][m][0] * rs, up = acc[ai][bj][m][1] * rs;
                    u32x2_t w; w.x = pack2(siluf_(g[0]) * up[0], siluf_(g[1]) * up[1]); w.y = pack2(siluf_(g[2]) * up[2], siluf_(g[3]) * up[3]);
                    *(u32x2_t*)(rowp + bj * 64) = w; } }
    }
};

struct ColSrc { const float* p; int ld; };
__device__ __forceinline__ ColSrc col_src(const Ctx& P, int layer, int mat, int r) {
    const int i = layer >> 1; const bool odd = layer & 1;
    ColSrc c; c.p = nullptr; c.ld = 0;
    if (mat == 0) { if (odd) { c.p = P.in[17] + (size_t)i * 1024 * 2816 + r; c.ld = 2816; } else if (r < 2316) { c.p = P.in[7] + (size_t)i * 1024 * 2316 + r; c.ld = 2316; } }
    else if (mat == 1) { c.p = (odd ? P.in[18] : P.in[8]) + (size_t)i * 1024 * 1024 + r; c.ld = 1024; }
    else if (mat == 2) { const int q = r >> 3, j = r & 7, f = 4 * q + (j & 3); c.p = (j < 4 ? P.in[3] : P.in[4]) + (size_t)layer * 1024 * 2816 + f; c.ld = 2816; }
    else { c.p = P.in[5] + (size_t)layer * 2816 * 1024 + r; c.ld = 1024; }
    return c;
}
struct ConvTile { int mat, rt, kt, K; bf16_t* dst; };
__device__ __forceinline__ ConvTile conv_tile(const Ctx& P, int tile, int n0, int n1, int n2) {
    ConvTile c;
    if (tile < n0) { c.mat = 0; c.K = 1024; c.rt = tile / 16; c.kt = tile % 16; c.dst = (bf16_t*)(P.ws + WS_WIN); }
    else if (tile < n0 + n1) { const int x = tile - n0; c.mat = 1; c.K = 1024; c.rt = x / 16; c.kt = x % 16; c.dst = (bf16_t*)(P.ws + WS_WOUT); }
    else if (tile < n0 + n1 + n2) { const int x = tile - n0 - n1; c.mat = 2; c.K = 1024; c.rt = x / 16; c.kt = x % 16; c.dst = (bf16_t*)(P.ws + WS_WGU); }
    else { const int x = tile - n0 - n1 - n2; c.mat = 3; c.K = 2816; c.rt = x / 44; c.kt = x % 44; c.dst = (bf16_t*)(P.ws + WS_WDN); }
    return c;
}
__device__ void phase_convert(const Ctx& P, int layer, unsigned char* shm) {
    float* T = (float*)shm;
    const bool odd = layer & 1; const int n0 = (odd ? 44 : 40) * 16, n1 = 256, n2 = 88 * 16, n3 = 16 * 44, ntot = n0 + n1 + n2 + n3;
    const int tid = ltid(), nblk = lnb();
    const int rr = tid & 63, kk = tid >> 6, r2 = tid >> 3, kq = tid & 7;
    for (int tile = lbid(); tile < ntot; tile += 2 * nblk) {
        const int tile2 = tile + nblk; const bool has2 = tile2 < ntot;
        const ConvTile c0 = conv_tile(P, tile, n0, n1, n2), c1 = conv_tile(P, has2 ? tile2 : tile, n0, n1, n2);
        const ColSrc s0 = col_src(P, layer, c0.mat, c0.rt * 64 + rr), s1 = col_src(P, layer, c1.mat, c1.rt * 64 + rr);
        const float* g0 = c0.mat == 0 ? P.in[1] + layer * DM : (c0.mat == 2 ? P.in[2] + layer * DM : nullptr);
        const float* g1 = c1.mat == 0 ? P.in[1] + layer * DM : (c1.mat == 2 ? P.in[2] + layer * DM : nullptr);
        float v0[8], v1[8];
#pragma unroll
        for (int k8 = 0; k8 < 8; ++k8) { const int k = k8 * 8 + kk;
            v0[k8] = s0.p ? s0.p[(size_t)(c0.kt * 64 + k) * s0.ld] * (g0 ? g0[c0.kt * 64 + k] : 1.0f) : 0.f;
            v1[k8] = s1.p ? s1.p[(size_t)(c1.kt * 64 + k) * s1.ld] * (g1 ? g1[c1.kt * 64 + k] : 1.0f) : 0.f; }
#pragma unroll
        for (int k8 = 0; k8 < 8; ++k8) { const int k = k8 * 8 + kk; T[k * 65 + rr] = v0[k8]; T[4160 + k * 65 + rr] = v1[k8]; }
        __syncthreads();
#pragma unroll
        for (int h2 = 0; h2 < 2; ++h2) { if (h2 == 1 && !has2) break; const int cK = h2 ? c1.K : c0.K, crt = h2 ? c1.rt : c0.rt, ckt = h2 ? c1.kt : c0.kt; bf16_t* cdst = h2 ? c1.dst : c0.dst; const float* Tt = T + h2 * 4160;
            uint4 w;
            w.x = pack2(Tt[(kq * 8 + 0) * 65 + r2], Tt[(kq * 8 + 1) * 65 + r2]); w.y = pack2(Tt[(kq * 8 + 2) * 65 + r2], Tt[(kq * 8 + 3) * 65 + r2]);
            w.z = pack2(Tt[(kq * 8 + 4) * 65 + r2], Tt[(kq * 8 + 5) * 65 + r2]); w.w = pack2(Tt[(kq * 8 + 6) * 65 + r2], Tt[(kq * 8 + 7) * 65 + r2]);
            *(uint4*)(cdst + (size_t)(crt * 64 + r2) * cK + ckt * 64 + kq * 8) = w; }
        __syncthreads();
    }
}

__device__ void phase_x_to_bf16(const float* h, bf16_t* out, float* ss) {
    const int lane = ltid() & 63, gw = lbid() * 8 + (ltid() >> 6), nw = lnb() * 8;
    for (int row = gw * 2; row < M_TOK; row += nw * 2) {
        const float4* p = (const float4*)(h + (size_t)row * DM);
        float4 v[8]; float s0 = 0.f, s1 = 0.f;
#pragma unroll
        for (int i = 0; i < 8; ++i) v[i] = p[lane + 64 * i];
#pragma unroll
        for (int i = 0; i < 4; ++i) { s0 += v[i].x * v[i].x + v[i].y * v[i].y + v[i].z * v[i].z + v[i].w * v[i].w; s1 += v[4 + i].x * v[4 + i].x + v[4 + i].y * v[4 + i].y + v[4 + i].z * v[4 + i].z + v[4 + i].w * v[4 + i].w; }
        s0 = wave_sum(s0); s1 = wave_sum(s1);
        if (lane == 0) { ss[row] = rsqrtf(s0 * (1.0f / 1024.0f) + 1e-6f); ss[row + 1] = rsqrtf(s1 * (1.0f / 1024.0f) + 1e-6f); }
#pragma unroll
        for (int i = 0; i < 8; ++i) { uint2 w; w.x = pack2(v[i].x, v[i].y); w.y = pack2(v[i].z, v[i].w); *(uint2*)(out + (size_t)row * DM + (lane + 64 * i) * 4) = w; }
    }
}
__device__ void phase_final_norm(const bf16_t* h, float* out, const float* g, const float* ss) {
    const int lane = ltid() & 63, gw = lbid() * 8 + (ltid() >> 6), nw = lnb() * 8;
    for (int row = gw * 2; row < M_TOK; row += nw * 2) {
        const float rs0 = row_rstd(ss, row), rs1 = row_rstd(ss, row + 1);
        uint4 hv[4];
#pragma unroll
        for (int i = 0; i < 4; ++i) hv[i] = *(const uint4*)(h + (size_t)row * DM + (lane + 64 * i) * 8);
#pragma unroll
        for (int i = 0; i < 4; ++i) { const int c8 = (lane + 64 * (i & 1)) * 8; float v[8]; unpack8(hv[i], v); const float rs = i < 2 ? rs0 : rs1;
            const float4 g0 = *(const float4*)(g + c8), g1 = *(const float4*)(g + c8 + 4); float4 o0, o1;
            o0.x = v[0] * rs * g0.x; o0.y = v[1] * rs * g0.y; o0.z = v[2] * rs * g0.z; o0.w = v[3] * rs * g0.w; o1.x = v[4] * rs * g1.x; o1.y = v[5] * rs * g1.y; o1.z = v[6] * rs * g1.z; o1.w = v[7] * rs * g1.w;
            float* op = out + (size_t)(row + (i >> 1)) * DM + c8; *(float4*)op = o0; *(float4*)(op + 4) = o1; }
    }
}
__device__ void finalize_rstd(const float* ssp, float* rstd) { for (int i = lbid() * 512 + ltid(); i < M_TOK; i += lnb() * 512) rstd[i] = row_rstd(ssp, i); }

__device__ __forceinline__ float* tokaux(bf16_t* Pb, int t) { return (float*)(Pb + (size_t)t * PP + 2560); }

__device__ void phase_even_prep(const Ctx& P, int layer) {
    const int i = layer >> 1;
    bf16_t* Pb = (bf16_t*)(P.ws + WS_P);
    bf16_t* XBC = (bf16_t*)(P.ws + WS_SC + SC_XBC);
    float* PD = (float*)(P.ws + WS_SC + SC_PD);
    const float* cw = P.in[11] + (size_t)i * 4 * 1280; const float* cb = P.in[12] + i * 1280; const float* dtb = P.in[13] + i * 12;
    const int gt = lbid() * 512 + ltid(), gs = lnb() * 512;
    for (int idx = gt; idx < 160 * 1024; idx += gs) {
        const int cg = idx % 160, run = idx / 160, c8 = cg * 8, tstart = run * 32;
        float wk[4][8], bias[8];
#pragma unroll
        for (int k = 0; k < 4; ++k) { const float4 a = *(const float4*)(cw + k * 1280 + c8), c = *(const float4*)(cw + k * 1280 + c8 + 4); wk[k][0] = a.x; wk[k][1] = a.y; wk[k][2] = a.z; wk[k][3] = a.w; wk[k][4] = c.x; wk[k][5] = c.y; wk[k][6] = c.z; wk[k][7] = c.w; }
        { const float4 a = *(const float4*)(cb + c8), c = *(const float4*)(cb + c8 + 4); bias[0] = a.x; bias[1] = a.y; bias[2] = a.z; bias[3] = a.w; bias[4] = c.x; bias[5] = c.y; bias[6] = c.z; bias[7] = c.w; }
        float h1[8], h2[8], h3[8];
        { const bool first = (tstart & (SEQ - 1)) == 0; const int back = first ? 0 : 1;
          const uint4 r1 = *(const uint4*)(Pb + (size_t)(tstart - back) * PP + 1024 + c8), r2 = *(const uint4*)(Pb + (size_t)(tstart - 2 * back) * PP + 1024 + c8), r3 = *(const uint4*)(Pb + (size_t)(tstart - 3 * back) * PP + 1024 + c8);
          unpack8(r1, h1); unpack8(r2, h2); unpack8(r3, h3);
          const float keep = first ? 0.f : 1.f;
#pragma unroll
          for (int j = 0; j < 8; ++j) { h1[j] *= keep; h2[j] *= keep; h3[j] *= keep; } }
#pragma unroll
        for (int tb = 0; tb < 32; tb += 8) {
            uint4 raw[8];
#pragma unroll
            for (int q = 0; q < 8; ++q) raw[q] = *(const uint4*)(Pb + (size_t)(tstart + tb + q) * PP + 1024 + c8);
#pragma unroll
            for (int q = 0; q < 8; ++q) { float x[8], o[8]; unpack8(raw[q], x);
#pragma unroll
                for (int j = 0; j < 8; ++j) { o[j] = siluf_(bias[j] + wk[0][j] * h3[j] + wk[1][j] * h2[j] + wk[2][j] * h1[j] + wk[3][j] * x[j]); h3[j] = h2[j]; h2[j] = h1[j]; h1[j] = x[j]; }
                *(uint4*)(XBC + (size_t)(tstart + tb + q) * 1280 + c8) = pack8(o); }
        }
    }
    for (int idx = gt; idx < M_TOK * 12; idx += gs) { const int t = idx / 12, e = idx % 12; tokaux(Pb, t)[e] = softplusf_(bf2f(Pb[(size_t)t * PP + 2304 + e]) + dtb[e]); }
    for (int idx = gt; idx < M_TOK * 32; idx += gs) {
        const int t = idx >> 5, c8 = (idx & 31) * 8, g = c8 >> 6, w = 2 << g, tp = t & (SEQ - 1), cnt = (tp + 1 < w) ? tp + 1 : w;
        float s[8], u[8];
#pragma unroll
        for (int j = 0; j < 8; ++j) { s[j] = 0.f; u[j] = 0.f; }
        uint4 rw[16];
#pragma unroll
        for (int q = 0; q < 16; ++q) { const int qq = q < cnt ? q : 0; rw[q] = *(const uint4*)(Pb + (size_t)(t - qq) * PP + c8); }
#pragma unroll
        for (int q = 0; q < 16; ++q) { const uint4 raw = rw[q]; const float m = q < cnt ? 1.0f : 0.0f;
            const float v0 = bflo(raw.x), v1 = bfhi(raw.x), v2 = bflo(raw.y), v3 = bfhi(raw.y), v4 = bflo(raw.z), v5 = bfhi(raw.z), v6 = bflo(raw.w), v7 = bfhi(raw.w);
            s[0] += m * v0; s[1] += m * v1; s[2] += m * v2; s[3] += m * v3; s[4] += m * v4; s[5] += m * v5; s[6] += m * v6; s[7] += m * v7;
            if (q == 0) { u[0] = v0; u[1] = v1; u[2] = v2; u[3] = v3; u[4] = v4; u[5] = v5; u[6] = v6; u[7] = v7; } }
        const float inv = 1.0f / (float)cnt;
        float4 d0, d1; d0.x = s[0] * inv - u[0]; d0.y = s[1] * inv - u[1]; d0.z = s[2] * inv - u[2]; d0.w = s[3] * inv - u[3]; d1.x = s[4] * inv - u[4]; d1.y = s[5] * inv - u[5]; d1.z = s[6] * inv - u[6]; d1.w = s[7] * inv - u[7];
        *(float4*)(PD + (size_t)t * 256 + c8) = d0; *(float4*)(PD + (size_t)t * 256 + c8 + 4) = d1;
    }
}

__device__ void phase_even_states(const Ctx& P, int layer, unsigned char* shm) {
    const int i = layer >> 1, tid = ltid();
    bf16_t* Pb = (bf16_t*)(P.ws + WS_P); bf16_t* YM = (bf16_t*)P.out;
    const bf16_t* XBC = (const bf16_t*)(P.ws + WS_SC + SC_XBC);
    const float* PD = (const float*)(P.ws + WS_SC + SC_PD);
    bf16_t* ST = (bf16_t*)(P.ws + WS_SC + SC_ST); float* CDEC = (float*)(P.ws + WS_MISC + MS_CDEC);
    {
        float* T = (float*)shm;
        const float* pw = P.in[9] + (size_t)i * 4 * 64 * 64; const float* psc = P.in[10] + i * 256;
        const int col = tid & 255, half = tid >> 8, g = col >> 6, j = col & 63;
        float wreg[64];
#pragma unroll
        for (int c = 0; c < 64; ++c) wreg[c] = pw[(g * 64 + c) * 64 + j];
        const float sc = psc[col];
        for (int unit = lbid(); unit < 512; unit += lnb()) {
            const int t0 = unit * 64;
#pragma unroll
            for (int q = 0; q < 8; ++q) { const int i4 = q * 512 + tid; ((float4*)T)[i4] = ((const float4*)(PD + (size_t)t0 * 256))[i4]; }
            __syncthreads();
            for (int tt = 0; tt < 32; ++tt) { const int tok = half * 32 + tt; const float4* row = (const float4*)(T + tok * 256 + g * 64); float acc = 0.f;
#pragma unroll
                for (int c4 = 0; c4 < 16; ++c4) { const float4 d = row[c4]; acc += d.x * wreg[4 * c4] + d.y * wreg[4 * c4 + 1] + d.z * wreg[4 * c4 + 2] + d.w * wreg[4 * c4 + 3]; }
                YM[(size_t)(t0 + tok) * DM + col] = f2bf(acc * sc); }
            __syncthreads();
        }
    }
    {
        bf16_t* Bm = (bf16_t*)shm;
        bf16_t* Cm = Bm + 128 * 136;
        bf16_t* BmT = Cm + 128 * 136;
        bf16_t* XST = BmT + 128 * 136;
        float* cum = (float*)(XST + 64 * 136); float* dts = cum + 768;
        const float* alog = P.in[14] + i * 12;
        const int wave = __builtin_amdgcn_readfirstlane(tid >> 6), lane = tid & 63, hf = lane >> 5, l31 = lane & 31;
        for (int unit = lbid(); unit < 512; unit += lnb()) {
            const int b = unit >> 8, c = (unit >> 1) & 127, g = unit & 1, t0 = b * SEQ + c * 128;
            __syncthreads();
#pragma unroll
            for (int idx = tid; idx < 128 * 16; idx += 512) { const int l = idx >> 4, n8 = (idx & 15) * 8;
                const uint4 rb = *(const uint4*)(XBC + (size_t)(t0 + l) * 1280 + 768 + g * 128 + n8);
                BmT[(n8 + 0) * 136 + l] = (bf16_t)(rb.x & 0xffffu); BmT[(n8 + 1) * 136 + l] = (bf16_t)(rb.x >> 16); BmT[(n8 + 2) * 136 + l] = (bf16_t)(rb.y & 0xffffu); BmT[(n8 + 3) * 136 + l] = (bf16_t)(rb.y >> 16);
                BmT[(n8 + 4) * 136 + l] = (bf16_t)(rb.z & 0xffffu); BmT[(n8 + 5) * 136 + l] = (bf16_t)(rb.z >> 16); BmT[(n8 + 6) * 136 + l] = (bf16_t)(rb.w & 0xffffu); BmT[(n8 + 7) * 136 + l] = (bf16_t)(rb.w >> 16); }
            for (int idx = tid; idx < 768; idx += 512) dts[idx] = tokaux(Pb, t0 + (idx & 127))[g * 6 + (idx >> 7)];
            __syncthreads();
            if (tid < 6) { const float a = -__expf(alog[g * 6 + tid]); float cs = 0.f;
#pragma unroll 8
                for (int l = 0; l < 128; ++l) { cs += dts[tid * 128 + l] * a; cum[tid * 128 + l] = cs; } }
            __syncthreads();
            for (int idx = tid; idx < 768; idx += 512) tokaux(Pb, t0 + (idx & 127))[12 + g * 6 + (idx >> 7)] = cum[idx];
            for (int e = 0; e < 6; ++e) { const int hh = g * 6 + e; const float cl = cum[e * 128 + 127];
                __syncthreads();
#pragma unroll
                for (int q = 0; q < 2; ++q) { const int item = tid + 512 * q, l = item >> 3, p8 = (item & 7) * 8;
                    const uint4 rx = *(const uint4*)(XBC + (size_t)(t0 + l) * 1280 + hh * 64 + p8); float x[8]; unpack8(rx, x);
                    const float sc = dts[e * 128 + l] * __expf(cl - cum[e * 128 + l]);
#pragma unroll
                    for (int j = 0; j < 8; ++j) XST[(p8 + j) * 136 + l] = f2bf(x[j] * sc); }
                __syncthreads();
                { const int pi = wave >> 2, ni = wave & 3; f32x16_t acc;
#pragma unroll
                  for (int q = 0; q < 16; ++q) acc[q] = 0.f;
#pragma unroll
                  for (int ks = 0; ks < 8; ++ks) { const int k = ks * 16 + 8 * hf;
                      const bf16x8_t fa = *(const bf16x8_t*)(XST + (pi * 32 + l31) * 136 + k), fb = *(const bf16x8_t*)(BmT + (ni * 32 + l31) * 136 + k); acc = __builtin_amdgcn_mfma_f32_32x32x16_bf16(fa, fb, acc, 0, 0, 0); }
                  bf16_t* so = ST + ((size_t)(b * 128 + c) * 12 + hh) * 8192 + (pi * 32 + 4 * hf) * 128 + ni * 32 + l31;
#pragma unroll
                  for (int q = 0; q < 16; ++q) so[((q & 3) + 8 * (q >> 2)) * 128] = f2bf(acc[q]); }
                if (tid == 0) CDEC[(b * 128 + c) * 12 + hh] = __expf(cl);
            }
        }
    }
}

__device__ void phase_even_pass(const Ctx& P) {
    bf16_t* ST = (bf16_t*)(P.ws + WS_SC + SC_ST); const float* CDEC = (const float*)(P.ws + WS_MISC + MS_CDEC);
    for (int gt = lbid() * 512 + ltid(); gt < 98304; gt += lnb() * 512) {
        const int b = gt / 49152, rem = gt % 49152, hh = rem >> 12, i2 = rem & 4095;
        float hx = 0.f, hy = 0.f;
        unsigned st[8], st2[8]; float dec[8], dec2[8];
#pragma unroll
        for (int q = 0; q < 8; ++q) { const size_t o = ((size_t)(b * 128 + q) * 12 + hh) * 8192 + i2 * 2; st[q] = *(const unsigned*)(ST + o); dec[q] = CDEC[(b * 128 + q) * 12 + hh]; }
        for (int c0 = 0; c0 < 128; c0 += 8) {
            const int cn = c0 + 8 < 128 ? c0 + 8 : c0;
#pragma unroll
            for (int q = 0; q < 8; ++q) { const size_t o = ((size_t)(b * 128 + cn + q) * 12 + hh) * 8192 + i2 * 2; st2[q] = *(const unsigned*)(ST + o); dec2[q] = CDEC[(b * 128 + cn + q) * 12 + hh]; }
#pragma unroll
            for (int q = 0; q < 8; ++q) { const size_t o = ((size_t)(b * 128 + c0 + q) * 12 + hh) * 8192 + i2 * 2; *(unsigned*)(ST + o) = pack2(hx, hy); hx = hx * dec[q] + bflo(st[q]); hy = hy * dec[q] + bfhi(st[q]); }
#pragma unroll
            for (int q = 0; q < 8; ++q) { st[q] = st2[q]; dec[q] = dec2[q]; }
        }
    }
}

__device__ void phase_even_out(const Ctx& P, int layer, unsigned char* shm) {
    const int i = layer >> 1, tid = ltid(), wave = __builtin_amdgcn_readfirstlane(tid >> 6), lane = tid & 63, hf = lane >> 5, l31 = lane & 31;
    bf16_t* Pb = (bf16_t*)(P.ws + WS_P); bf16_t* YM = (bf16_t*)P.out;
    const bf16_t* XBC = (const bf16_t*)(P.ws + WS_SC + SC_XBC);
    const bf16_t* ST = (const bf16_t*)(P.ws + WS_SC + SC_ST);
    const float* dsk = P.in[15] + i * 12; const float* ng = P.in[16] + i * 768;
    bf16_t* Cm = (bf16_t*)shm;
    bf16_t* Mb = Cm + 128 * 136;
    bf16_t* XT = Mb + 128 * 136;
    bf16_t* PV = XT + 64 * 136;
    float* cumL = (float*)(PV + 64 * 136); float* dtL = cumL + 128; float* SSQ = dtL + 128;
    bf16_t* CBb = (bf16_t*)(SSQ + 256);
    const int li = wave >> 1, pi = wave & 1, p = pi * 32 + l31;
    for (int unit = lbid(); unit < 512; unit += lnb()) {
        const int b = unit >> 8, c = (unit >> 1) & 127, g = unit & 1, t0 = b * SEQ + c * 128;
        __syncthreads();
#pragma unroll
        for (int idx = tid; idx < 128 * 16; idx += 512) { const int l = idx >> 4, n8 = (idx & 15) * 8; *(uint4*)(Cm + l * 136 + n8) = *(const uint4*)(XBC + (size_t)(t0 + l) * 1280 + 1024 + g * 128 + n8);
            *(uint4*)(Mb + l * 136 + n8) = *(const uint4*)(XBC + (size_t)(t0 + l) * 1280 + 768 + g * 128 + n8); }
        __syncthreads();
        {
#pragma unroll
            for (int sj = 0; sj < 2; ++sj) { const int si = (wave & 1) * 2 + sj; f32x16_t acc;
#pragma unroll
                for (int q = 0; q < 16; ++q) acc[q] = 0.f;
#pragma unroll
                for (int ks = 0; ks < 8; ++ks) { const int k = ks * 16 + 8 * hf;
                    const bf16x8_t fa = *(const bf16x8_t*)(Cm + (li * 32 + l31) * 136 + k), fb = *(const bf16x8_t*)(Mb + (si * 32 + l31) * 136 + k); acc = __builtin_amdgcn_mfma_f32_32x32x16_bf16(fa, fb, acc, 0, 0, 0); }
#pragma unroll
                for (int q = 0; q < 16; ++q) CBb[(li * 32 + 4 * hf + (q & 3) + 8 * (q >> 2)) * 136 + si * 32 + l31] = f2bf(acc[q]); } }

        float ssq[16];
#pragma unroll
        for (int reg = 0; reg < 16; ++reg) ssq[reg] = 0.f;
#pragma unroll 1
        for (int e = 0; e < 6; ++e) {
            const int hh = g * 6 + e;
            __syncthreads();
            if (tid < 128) { const float* ax = tokaux(Pb, t0 + tid); cumL[tid] = ax[12 + hh]; dtL[tid] = ax[hh]; }
            __syncthreads();
#pragma unroll 2
            for (int q = 0; q < 4; ++q) { const int item = tid + 512 * q, l = item >> 4, s8 = (item & 15) * 8;
                float v[8]; unpack8(*(const uint4*)(CBb + l * 136 + s8), v); const float cl_ = cumL[l];
#pragma unroll
                for (int j = 0; j < 8; ++j) { const int s = s8 + j; v[j] = (s <= l) ? v[j] * __expf(fminf(cl_ - cumL[s], 0.f)) * dtL[s] : 0.f; }
                *(uint4*)(Mb + l * 136 + s8) = pack8(v); }
#pragma unroll
            for (int q = 0; q < 2; ++q) { const int item = tid + 512 * q, s = item >> 3, p8 = (item & 7) * 8;
                const uint4 rx = *(const uint4*)(XBC + (size_t)(t0 + s) * 1280 + hh * 64 + p8);
                XT[(p8 + 0) * 136 + s] = (bf16_t)(rx.x & 0xffffu); XT[(p8 + 1) * 136 + s] = (bf16_t)(rx.x >> 16); XT[(p8 + 2) * 136 + s] = (bf16_t)(rx.y & 0xffffu); XT[(p8 + 3) * 136 + s] = (bf16_t)(rx.y >> 16);
                XT[(p8 + 4) * 136 + s] = (bf16_t)(rx.z & 0xffffu); XT[(p8 + 5) * 136 + s] = (bf16_t)(rx.z >> 16); XT[(p8 + 6) * 136 + s] = (bf16_t)(rx.w & 0xffffu); XT[(p8 + 7) * 136 + s] = (bf16_t)(rx.w >> 16); }
#pragma unroll
            for (int q = 0; q < 2; ++q) { const int item = tid + 512 * q, pp = item >> 4, n8 = (item & 15) * 8;
                *(uint4*)(PV + pp * 136 + n8) = *(const uint4*)(ST + ((size_t)(b * 128 + c) * 12 + hh) * 8192 + pp * 128 + n8); }
            __syncthreads();
            bf16_t zr[16];
#pragma unroll
            for (int reg = 0; reg < 16; ++reg) zr[reg] = Pb[(size_t)(t0 + li * 32 + 4 * hf + (reg & 3) + 8 * (reg >> 2)) * PP + 256 + hh * 64 + p];
            f32x16_t ad, ao;
#pragma unroll
            for (int q = 0; q < 16; ++q) { ad[q] = 0.f; ao[q] = 0.f; }
            const int nks = (li + 1) * 2;
#pragma unroll
            for (int ks = 0; ks < 8; ++ks) { const int k = ks * 16 + 8 * hf;
                if (ks < nks) { const bf16x8_t fa = *(const bf16x8_t*)(Mb + (li * 32 + l31) * 136 + k), fb = *(const bf16x8_t*)(XT + (pi * 32 + l31) * 136 + k); ad = __builtin_amdgcn_mfma_f32_32x32x16_bf16(fa, fb, ad, 0, 0, 0); }
                const bf16x8_t ga = *(const bf16x8_t*)(Cm + (li * 32 + l31) * 136 + k), gb = *(const bf16x8_t*)(PV + (pi * 32 + l31) * 136 + k); ao = __builtin_amdgcn_mfma_f32_32x32x16_bf16(ga, gb, ao, 0, 0, 0); }
            const float dk = dsk[hh];
#pragma unroll
            for (int reg = 0; reg < 16; ++reg) { const int rl_ = li * 32 + 4 * hf; const int row = rl_ + (reg & 3) + 8 * (reg >> 2);
                const float el = __expf(cumL[row]), xlp = bf2f(XT[p * 136 + row]);
                float y = ad[reg] + el * ao[reg] + dk * xlp;
                y *= siluf_(bf2f(zr[reg]));
                ssq[reg] += y * y;
                YM[(size_t)(t0 + row) * DM + 256 + g * 384 + e * 64 + p] = f2bf(y); }
        }
#pragma unroll
        for (int reg = 0; reg < 16; ++reg) { const int row = li * 32 + 4 * hf + (reg & 3) + 8 * (reg >> 2); const float s = half32_sum(ssq[reg]); if (l31 == 0) SSQ[row * 2 + pi] = s; }
        __syncthreads();
#pragma unroll
        for (int reg = 0; reg < 16; ++reg) { const int row = li * 32 + 4 * hf + (reg & 3) + 8 * (reg >> 2); ssq[reg] = rsqrtf((SSQ[row * 2] + SSQ[row * 2 + 1]) * (1.0f / 384.0f) + 1e-6f); }
#pragma unroll 1
        for (int e = 0; e < 6; ++e) { const float gn = ng[g * 384 + e * 64 + p]; bf16_t* yb = YM + (size_t)(t0 + li * 32 + 4 * hf) * DM + 256 + g * 384 + e * 64 + p; bf16_t yv[16];
#pragma unroll
            for (int reg = 0; reg < 16; ++reg) yv[reg] = yb[(size_t)((reg & 3) + 8 * (reg >> 2)) * DM];
#pragma unroll
            for (int reg = 0; reg < 16; ++reg) yb[(size_t)((reg & 3) + 8 * (reg >> 2)) * DM] = f2bf(bf2f(yv[reg]) * ssq[reg] * gn); }
    }
}

__device__ void phase_odd_prep(const Ctx& P, int layer, unsigned char* shm, bool dry = false) {
    const int i = layer >> 1, tid = ltid(), wave = __builtin_amdgcn_readfirstlane(tid >> 6), lane = tid & 63;
    const int bid = lbid(), nblk = lnb(), h = bid & 7;
    bf16_t* Pb = (bf16_t*)(P.ws + WS_P); bf16_t* YM = (bf16_t*)P.out;
    float* SCW = (float*)(P.ws + WS_SC + SC_W); bf16_t* SCKK = (bf16_t*)(P.ws + WS_SC + SC_KK); bf16_t* SCB = (bf16_t*)(P.ws + WS_SC + SC_B);
    const bf16_t* BND = (const bf16_t*)(P.ws + WS_MISC + MS_BND); float2* AGG = (float2*)(P.ws + WS_MISC + MS_AGG); float* BS = (float*)(P.ws + WS_MISC + MS_BS);
    bf16_t* WU = (bf16_t*)shm;
    bf16_t* AU = WU + 64 * 72;
    bf16_t* GU = AU + 64 * 72;
    bf16_t* WA = GU + 64 * 136;
    bf16_t* WX = WA + 64 * 72;
    bf16_t* AT = WX + 64 * 72;
    bf16_t* AA = AT + 128 * 72;
    bf16_t* AG = AA + 128 * 72;
    bf16_t* AX = AG + 128 * 136;
    float* RED = (float*)(AX + 128 * 72);
    float* AGL = RED + 512;
    bf16_t* RKV = AT;
    const float* mu = P.in[19] + i * 1792;
    const float* w_up = P.in[21] + (size_t)i * 64 * 512; const float* a_up = P.in[23] + (size_t)i * 64 * 512; const float* g_up = P.in[24] + (size_t)i * 128 * 512;
    const float* lcw = P.in[30] + i * 4 * 512; const float* lcb = P.in[31] + i * 512;
    const float* wa = P.in[32] + (size_t)i * 8 * 64 * 64; const float* wx = P.in[34] + (size_t)i * 8 * 64 * 64;
#pragma unroll
    for (int q = 0; q < 8; ++q) { const int e = tid + 512 * q, k = e >> 6, n = e & 63;
        WU[n * 72 + k] = f2bf(w_up[k * 512 + h * 64 + n]); AU[n * 72 + k] = f2bf(a_up[k * 512 + h * 64 + n]);
        WA[n * 72 + k] = f2bf(wa[(h * 64 + k) * 64 + n]); WX[n * 72 + k] = f2bf(wx[(h * 64 + k) * 64 + n]); }
#pragma unroll
    for (int q = 0; q < 16; ++q) { const int e = tid + 512 * q, k = e >> 6, n = e & 63; GU[n * 136 + k] = f2bf(g_up[k * 512 + h * 64 + n]); }
    const int tb = wave >> 1, nb = wave & 1, n = nb * 32 + (lane & 31), hf = lane >> 5, c = h * 64 + n;
    const float mu_r = mu[c], mu_k = mu[512 + c], mu_v = mu[1024 + c];
    const float w0 = P.in[20][i * 512 + c], a0 = P.in[22][i * 512 + c], k_k = P.in[25][i * 512 + c], k_a = P.in[26][i * 512 + c], r_k = P.in[27][i * 512 + c];
    const float ba = P.in[33][i * 512 + c], bx = P.in[35][i * 512 + c], sp = softplusf_(-P.in[36][i * 512 + c]);
    for (int tile = bid >> 3; tile < 256; tile += nblk >> 3) {
        const int t0 = tile * 128; const bool first = (t0 & (SEQ - 1)) == 0;
        __syncthreads();
#pragma unroll 4
        for (int q = 0; q < 8; ++q) { const int item = tid + 512 * q, t = item >> 5, cg = item & 31; const size_t tg = (size_t)t0 + t;
            const uint4 raw = *(const uint4*)(Pb + tg * PP + 1536 + cg * 8);
            uint4 prv; prv.x = 0u; prv.y = 0u; prv.z = 0u; prv.w = 0u; if ((tg & (SEQ - 1)) != 0) prv = *(const uint4*)(Pb + (tg - 1) * PP + 1536 + cg * 8);
            float a[8], p[8]; unpack8(raw, a); unpack8(prv, p);
            const float4 m0 = *(const float4*)(mu + 1536 + cg * 8), m1 = *(const float4*)(mu + 1536 + cg * 8 + 4); const float mm[8] = {m0.x, m0.y, m0.z, m0.w, m1.x, m1.y, m1.z, m1.w};
#pragma unroll
            for (int e = 0; e < 8; ++e) { const float s = a[e] + mm[e] * (p[e] - a[e]); a[e] = cg < 8 ? tanhf_(s) : (cg < 16 ? s : sigmoidf_(s)); }
            bf16_t* dst = cg < 8 ? AT + t * 72 + cg * 8 : (cg < 16 ? AA + t * 72 + (cg - 8) * 8 : AG + t * 136 + (cg - 16) * 8);
            *(uint4*)dst = pack8(a); }
#pragma unroll
        for (int q = 0; q < 2; ++q) { const int item = tid + 512 * q, t = item >> 3, cg = item & 7, cc = h * 64 + cg * 8;
            float acc[8]; { const float4 b0 = *(const float4*)(lcb + cc), b1 = *(const float4*)(lcb + cc + 4); acc[0] = b0.x; acc[1] = b0.y; acc[2] = b0.z; acc[3] = b0.w; acc[4] = b1.x; acc[5] = b1.y; acc[6] = b1.z; acc[7] = b1.w; }
#pragma unroll
            for (int d = 0; d < 4; ++d) { const int tr = t - d; uint4 raw; raw.x = 0u; raw.y = 0u; raw.z = 0u; raw.w = 0u;
                if (tr >= 0) raw = *(const uint4*)(Pb + ((size_t)t0 + tr) * PP + 2304 + cc);
                else if (!first) raw = *(const uint4*)(BND + ((size_t)(tile - 1) * 3 + 3 + tr) * PP + 2304 + cc);
                float x[8]; unpack8(raw, x); const float4 w0v = *(const float4*)(lcw + (3 - d) * 512 + cc), w1v = *(const float4*)(lcw + (3 - d) * 512 + cc + 4);
                acc[0] += w0v.x * x[0]; acc[1] += w0v.y * x[1]; acc[2] += w0v.z * x[2]; acc[3] += w0v.w * x[3]; acc[4] += w1v.x * x[4]; acc[5] += w1v.y * x[5]; acc[6] += w1v.z * x[6]; acc[7] += w1v.w * x[7]; }
            *(uint4*)(AX + t * 72 + cg * 8) = pack8(acc); }
        __syncthreads();
        f32x16_t cw_, ca_, cg_, cr_, ci_;
#pragma unroll
        for (int e = 0; e < 16; ++e) { cw_[e] = 0.f; ca_[e] = 0.f; cg_[e] = 0.f; cr_[e] = 0.f; ci_[e] = 0.f; }
        { const int ar = tb * 32 + (lane & 31), bn = nb * 32 + (lane & 31), ko = 8 * hf;
#pragma unroll
          for (int ks = 0; ks < 4; ++ks) { const int k = ks * 16 + ko;
              const bf16x8_t fa = *(const bf16x8_t*)(AT + ar * 72 + k), fb = *(const bf16x8_t*)(WU + bn * 72 + k); cw_ = __builtin_amdgcn_mfma_f32_32x32x16_bf16(fa, fb, cw_, 0, 0, 0);
              const bf16x8_t ga = *(const bf16x8_t*)(AA + ar * 72 + k), gb = *(const bf16x8_t*)(AU + bn * 72 + k); ca_ = __builtin_amdgcn_mfma_f32_32x32x16_bf16(ga, gb, ca_, 0, 0, 0);
              const bf16x8_t xa = *(const bf16x8_t*)(AX + ar * 72 + k), xb1 = *(const bf16x8_t*)(WA + bn * 72 + k), xb2 = *(const bf16x8_t*)(WX + bn * 72 + k);
              cr_ = __builtin_amdgcn_mfma_f32_32x32x16_bf16(xa, xb1, cr_, 0, 0, 0); ci_ = __builtin_amdgcn_mfma_f32_32x32x16_bf16(xa, xb2, ci_, 0, 0, 0); }
#pragma unroll
          for (int ks = 0; ks < 8; ++ks) { const int k = ks * 16 + ko; const bf16x8_t fa = *(const bf16x8_t*)(AG + ar * 136 + k), fb = *(const bf16x8_t*)(GU + bn * 136 + k); cg_ = __builtin_amdgcn_mfma_f32_32x32x16_bf16(fa, fb, cg_, 0, 0, 0); } }
        __syncthreads();
#pragma unroll
        for (int q = 0; q < 7; ++q) { const int item = tid + 512 * q; if (item < 129 * 32) { const int rr = item >> 5, part = item & 31, arr = part >> 3, cg = part & 7;
            const int col = (arr < 3 ? arr * 512 : 1792) + h * 64 + cg * 8;
            uint4 raw; raw.x = 0u; raw.y = 0u; raw.z = 0u; raw.w = 0u;
            if (rr > 0) raw = *(const uint4*)(Pb + ((size_t)t0 + rr - 1) * PP + col);
            else if (!first) raw = *(const uint4*)(BND + ((size_t)(tile - 1) * 3 + 2) * PP + col);
            *(uint4*)(RKV + rr * 264 + arr * 64 + cg * 8) = raw; } }
        for (int item = tid + 512 * 7; item < 129 * 32; item += 512) { const int rr = item >> 5, part = item & 31, arr = part >> 3, cg = part & 7;
            const int col = (arr < 3 ? arr * 512 : 1792) + h * 64 + cg * 8;
            *(uint4*)(RKV + rr * 264 + arr * 64 + cg * 8) = *(const uint4*)(Pb + ((size_t)t0 + rr - 1) * PP + col); }
        __syncthreads();
#pragma unroll
        for (int reg = 0; reg < 16; ++reg) { int rl_ = tb * 32 + 4 * hf; asm volatile("" : "+v"(rl_)); const int row = rl_ + (reg & 3) + 8 * (reg >> 2);
            const float rr_ = bf2f(RKV[(row + 1) * 264 + n]), rk_ = bf2f(RKV[(row + 1) * 264 + 64 + n]), pr_ = bf2f(RKV[row * 264 + n]), pk_ = bf2f(RKV[row * 264 + 64 + n]);
            const float rs = rr_ + mu_r * (pr_ - rr_), ks = rk_ + mu_k * (pk_ - rk_);
            const float a = sigmoidf_(a0 + ca_[reg]); const float kk = ks * k_k, k2 = ks * (1.0f + (a - 1.0f) * k_a);
            const float ss = half32_sum(kk * kk), bsum = half32_sum(rs * k2 * r_k);
            if ((lane & 31) == 0) { RED[(row * 2 + nb) * 2] = ss; RED[(row * 2 + nb) * 2 + 1] = bsum; }
            }
        __syncthreads();
        float segL[4], segH[4];
#pragma unroll
        for (int reg = 0; reg < 16; ++reg) { int rl_ = tb * 32 + 4 * hf; asm volatile("" : "+v"(rl_)); const int row = rl_ + (reg & 3) + 8 * (reg >> 2); const size_t t = (size_t)t0 + row; bf16_t* prow = Pb + t * PP;
            const float rr_ = bf2f(RKV[(row + 1) * 264 + n]), rk_ = bf2f(RKV[(row + 1) * 264 + 64 + n]), rv_ = bf2f(RKV[(row + 1) * 264 + 128 + n]);
            const float pr_ = bf2f(RKV[row * 264 + n]), pk_ = bf2f(RKV[row * 264 + 64 + n]), pv_ = bf2f(RKV[row * 264 + 128 + n]);
            const float rs = rr_ + mu_r * (pr_ - rr_), ks = rk_ + mu_k * (pk_ - rk_), vs = rv_ + mu_v * (pv_ - rv_);
            const float wl = -softplusf_(-(w0 + cw_[reg])) - 0.5f; const float wdec = __expf(-__expf(wl));
            const float a = sigmoidf_(a0 + ca_[reg]); const float kk = ks * k_k, k2 = ks * (1.0f + (a - 1.0f) * k_a);
            const float ss = RED[(row * 2) * 2] + RED[(row * 2 + 1) * 2]; const float kkn = kk * rsqrtf(ss + 1e-12f), bq = kkn * a;
            if (nb == 0 && (lane & 31) == 0) BS[t * 8 + h] = RED[(row * 2) * 2 + 1] + RED[(row * 2 + 1) * 2 + 1];
            const float gtv = bf2f(RKV[(row + 1) * 264 + 192 + n]);
            bf16_t* pst = dry ? (bf16_t*)(P.ws + WS_SC + 192 * MiB) + (t & 8191) * PP : prow;
            pst[c] = f2bf(rs); pst[512 + c] = f2bf(k2); pst[1024 + c] = f2bf(vs);
            SCW[t * 512 + c] = wdec; SCKK[t * 512 + c] = f2bf(kkn); SCB[t * 512 + c] = f2bf(bq); YM[t * DM + c] = f2bf(cg_[reg]);
            const float rg = sigmoidf_(cr_[reg] + ba), ig = sigmoidf_(ci_[reg] + bx); const float la = -8.0f * rg * sp; const bf16_t la_b = f2bf(la); const float la_r = bf2f(la_b);
            const float mult = __builtin_sqrtf(fmaxf(1.0f - __expf(2.0f * la), 0.f)); const float bl = mult * ig * bf2f(AX[row * 72 + n]); const bf16_t bl_b = f2bf(bl);
            YM[t * DM + 512 + c] = f2bf(gelu_tanh_(gtv)); pst[1792 + c] = la_b; pst[2304 + c] = bl_b;
            if ((reg & 3) == 0) { segL[reg >> 2] = la_r; segH[reg >> 2] = bf2f(bl_b); } else { segL[reg >> 2] += la_r; segH[reg >> 2] = __expf(la_r) * segH[reg >> 2] + bf2f(bl_b); }
            }
        { float L = 0.f, H = 0.f;
#pragma unroll
          for (int r = 0; r < 4; ++r) { const float oL = __shfl_xor(segL[r], 32), oH = __shfl_xor(segH[r], 32);
              const float L0 = hf ? oL : segL[r], H0 = hf ? oH : segH[r], L1 = hf ? segL[r] : oL, H1 = hf ? segH[r] : oH;
              H = __expf(L0) * H + H0; L += L0; H = __expf(L1) * H + H1; L += L1; }
          if (hf == 0) { AGL[(tb * 64 + n) * 2] = L; AGL[(tb * 64 + n) * 2 + 1] = H; } }
        __syncthreads();
        if (tid < 64) { float L = 0.f, H = 0.f;
#pragma unroll
            for (int r = 0; r < 4; ++r) { const float Ls = AGL[(r * 64 + tid) * 2], Hs = AGL[(r * 64 + tid) * 2 + 1]; H = __expf(Ls) * H + Hs; L += Ls; }
            AGG[tile * 512 + h * 64 + tid] = make_float2(L, H); }
    }
}

#define RING_BAR() do { asm volatile("s_waitcnt lgkmcnt(0)" ::: "memory"); __builtin_amdgcn_s_barrier(); asm volatile("" ::: "memory"); } while (0)
struct ScanStep { float4 w; uint2 kk, bb, kv, rv; float vv; };
__device__ void phase_odd_scan(const Ctx& P, unsigned char* shm) {
    const int tid = ltid(), wave = __builtin_amdgcn_readfirstlane(tid >> 6), lane = tid & 63;
    bf16_t* Pb = (bf16_t*)(P.ws + WS_P); bf16_t* YM = (bf16_t*)P.out;
    const float2* AGG = (const float2*)(P.ws + WS_MISC + MS_AGG);
    for (int task = lbid() * 8 + wave; task < 2048; task += lnb() * 8) {
        const int tile = task >> 3, c = (task & 7) * 64 + lane;
        float h = 0.f;
#pragma unroll 8
        for (int i = tile & ~127; i < tile; ++i) { const float2 ag = AGG[i * 512 + c]; h = __expf(ag.x) * h + ag.y; }
        {
            bf16_t la[8], bl[8], gg[8], la2[8], bl2[8], gg2[8];
#pragma unroll
            for (int q = 0; q < 8; ++q) { const size_t t = (size_t)tile * 128 + q; la[q] = Pb[t * PP + 1792 + c]; bl[q] = Pb[t * PP + 2304 + c]; gg[q] = YM[t * DM + 512 + c]; }
            for (int tb = 0; tb < 128; tb += 8) {
                const int tn = tb + 8 < 128 ? tb + 8 : tb;
#pragma unroll
                for (int q = 0; q < 8; ++q) { const size_t t = (size_t)tile * 128 + tn + q; la2[q] = Pb[t * PP + 1792 + c]; bl2[q] = Pb[t * PP + 2304 + c]; gg2[q] = YM[t * DM + 512 + c]; }
#pragma unroll
                for (int q = 0; q < 8; ++q) { const size_t t = (size_t)tile * 128 + tb + q; h = __expf(bf2f(la[q])) * h + bf2f(bl[q]); YM[t * DM + 512 + c] = f2bf(h * bf2f(gg[q])); }
#pragma unroll
                for (int q = 0; q < 8; ++q) { la[q] = la2[q]; bl[q] = bl2[q]; gg[q] = gg2[q]; }
            }
        }
    }
    __syncthreads();
#ifdef SCAN_TWICE
    for (int rep_ = 0; rep_ < 2; ++rep_)
#endif
    {
        typedef float f32x2 __attribute__((ext_vector_type(2)));
        const float* __restrict__ SCW = (const float*)(P.ws + WS_SC + SC_W); const bf16_t* __restrict__ SCKK = (const bf16_t*)(P.ws + WS_SC + SC_KK); const bf16_t* __restrict__ SCB = (const bf16_t*)(P.ws + WS_SC + SC_B);
        float* SCY = (float*)(P.ws + WS_SC + SC_Y);
        constexpr int CH = 32, NCH = SEQ / CH, BUFF = 16384;
        float* ring = (float*)shm;
        for (int task = lbid(); task < 256; task += lnb()) {
            const int xcd = task & 7, slot = task >> 3, bh = xcd * 2 + (slot >> 4), b = bh >> 3, hd = bh & 7, v0 = (slot & 15) * 4;
            const size_t tokb = (size_t)b * SEQ;
            if (wave != 0) {
                const int role = wave - 1;
                uint4 ra[4], rb[4];
#define RW_ISSUE(r, t0_) do { \
                    if (role < 2) { _Pragma("unroll") for (int i_ = 0; i_ < 4; ++i_) { const int idx_ = role * 256 + i_ * 64 + lane; const size_t tk_ = tokb + (t0_) + (idx_ >> 4); r[i_] = *(const uint4*)(SCW + tk_ * 512 + hd * 64 + 4 * (idx_ & 15)); } } \
                    else if (role < 5) { const bf16_t* sb_ = role == 2 ? SCKK + hd * 64 : (role == 3 ? SCB + hd * 64 : Pb + hd * 64); const size_t pitch_ = role == 4 ? PP : 512; \
                        _Pragma("unroll") for (int i_ = 0; i_ < 4; ++i_) { const int ia_ = (2 * i_) * 64 + lane, ib_ = (2 * i_ + 1) * 64 + lane; \
                            const uint2 a_ = *(const uint2*)(sb_ + (tokb + (t0_) + (ia_ >> 4)) * pitch_ + 4 * (ia_ & 15)), c_ = *(const uint2*)(sb_ + (tokb + (t0_) + (ib_ >> 4)) * pitch_ + 4 * (ib_ & 15)); \
                            r[i_].x = a_.x; r[i_].y = a_.y; r[i_].z = c_.x; r[i_].w = c_.y; } } \
                    else { _Pragma("unroll") for (int i_ = 0; i_ < 4; ++i_) { const int idx_ = (role - 5) * 256 + i_ * 64 + lane; const bf16_t* row_ = Pb + (tokb + (t0_) + (idx_ >> 4)) * PP + hd * 64; \
                            const uint2 a_ = *(const uint2*)(row_ + 512 + 4 * (idx_ & 15)), c_ = *(const uint2*)(row_ + 1024 + v0); r[i_].x = a_.x; r[i_].y = a_.y; r[i_].z = c_.x; r[i_].w = c_.y; } } } while (0)
#define RW_COMMIT(r, buf_) do { float* base_ = ring + (buf_) * BUFF; \
                    if (role < 2) { _Pragma("unroll") for (int i_ = 0; i_ < 4; ++i_) { const int idx_ = role * 256 + i_ * 64 + lane; *(uint4*)(base_ + (idx_ >> 4) * 64 + 4 * (idx_ & 15)) = r[i_]; } } \
                    else if (role < 5) { float* ab_ = base_ + 2048 * (role - 1); \
                        _Pragma("unroll") for (int i_ = 0; i_ < 4; ++i_) { const int ia_ = (2 * i_) * 64 + lane, ib_ = (2 * i_ + 1) * 64 + lane; float4 o_; \
                            o_.x = bflo(r[i_].x); o_.y = bfhi(r[i_].x); o_.z = bflo(r[i_].y); o_.w = bfhi(r[i_].y); *(float4*)(ab_ + (ia_ >> 4) * 64 + 4 * (ia_ & 15)) = o_; \
                            o_.x = bflo(r[i_].z); o_.y = bfhi(r[i_].z); o_.z = bflo(r[i_].w); o_.w = bfhi(r[i_].w); *(float4*)(ab_ + (ib_ >> 4) * 64 + 4 * (ib_ & 15)) = o_; } } \
                    else { _Pragma("unroll") for (int i_ = 0; i_ < 4; ++i_) { const int idx_ = (role - 5) * 256 + i_ * 64 + lane; float* d_ = base_ + 8192 + (idx_ >> 4) * 256 + 4 * (idx_ & 15); \
                            const float k0_ = bflo(r[i_].x), k1_ = bfhi(r[i_].x), k2_ = bflo(r[i_].y), k3_ = bfhi(r[i_].y), va_ = bflo(r[i_].z), vb_ = bfhi(r[i_].z), vc_ = bflo(r[i_].w), vd_ = bfhi(r[i_].w); float4 t_; \
                            t_.x = k0_ * va_; t_.y = k1_ * va_; t_.z = k2_ * va_; t_.w = k3_ * va_; *(float4*)d_ = t_; \
                            t_.x = k0_ * vb_; t_.y = k1_ * vb_; t_.z = k2_ * vb_; t_.w = k3_ * vb_; *(float4*)(d_ + 64) = t_; \
                            t_.x = k0_ * vc_; t_.y = k1_ * vc_; t_.z = k2_ * vc_; t_.w = k3_ * vc_; *(float4*)(d_ + 128) = t_; \
                            t_.x = k0_ * vd_; t_.y = k1_ * vd_; t_.z = k2_ * vd_; t_.w = k3_ * vd_; *(float4*)(d_ + 192) = t_; } } } while (0)
                RW_ISSUE(ra, 0); RW_COMMIT(ra, 0); RW_ISSUE(rb, CH); RW_ISSUE(ra, 2 * CH);
                RING_BAR();
                for (int ci = 0; ci < NCH; ci += 2) {
                    RW_COMMIT(rb, 1); if (ci + 3 < NCH) RW_ISSUE(rb, (ci + 3) * CH);
                    RING_BAR();
                    if (ci + 2 < NCH) { RW_COMMIT(ra, 0); if (ci + 4 < NCH) RW_ISSUE(ra, (ci + 4) * CH); }
                    RING_BAR();
                }
#undef RW_ISSUE
#undef RW_COMMIT
            } else {
                const int q = lane >> 4, j = lane & 15;
                f32x2 s01 = {0.f, 0.f}, s23 = {0.f, 0.f};
                const bool odd1 = (j & 1) != 0, odd2 = (j & 2) != 0; const int jq = j >> 2;
                float* yout = SCY + tokb * 512 + hd * 64 + v0 + (size_t)(4 * (j >> 2) + 2 * (j & 1) + ((j >> 1) & 1)) * 512 + q;
                RING_BAR();
                for (int ci = 0; ci < NCH; ++ci) {
                    const float* B = ring + (ci & 1) * BUFF;
                    float4 Lw[3], Lkk[3], Lbb[3], Lrv[3], Lvk[3];
#define SC_LD(sl_, u_) do { Lw[sl_] = *(const float4*)(B + (u_) * 64 + 4 * j); Lkk[sl_] = *(const float4*)(B + 2048 + (u_) * 64 + 4 * j); Lbb[sl_] = *(const float4*)(B + 4096 + (u_) * 64 + 4 * j); \
                        Lrv[sl_] = *(const float4*)(B + 6144 + (u_) * 64 + 4 * j); Lvk[sl_] = *(const float4*)(B + 8192 + (u_) * 256 + q * 64 + 4 * j); } while (0)
                    SC_LD(0, 0); SC_LD(1, 1);
                    float yacc = 0.f, yp0 = 0.f, yp1 = 0.f, yp2 = 0.f, yp3 = 0.f;
#pragma unroll
                    for (int u = 0; u < 32; ++u) {
                        if (u + 2 < 32) SC_LD((u + 2) % 3, u + 2);
                        if (u > 0 && (u & 3) == 0) {
                            const float sa_ = odd1 ? yp2 : yp0, sb_ = odd1 ? yp3 : yp1, ta_ = odd1 ? yp0 : yp2, tb_ = odd1 ? yp1 : yp3;
                            const float n0 = sa_ + __builtin_bit_cast(float, __builtin_amdgcn_update_dpp(0, __builtin_bit_cast(int, ta_), 0xB1, 0xF, 0xF, true));
                            const float n1 = sb_ + __builtin_bit_cast(float, __builtin_amdgcn_update_dpp(0, __builtin_bit_cast(int, tb_), 0xB1, 0xF, 0xF, true));
                            const float sc_ = odd2 ? n1 : n0, tc_ = odd2 ? n0 : n1;
                            float m_ = sc_ + __builtin_bit_cast(float, __builtin_amdgcn_update_dpp(0, __builtin_bit_cast(int, tc_), 0x4E, 0xF, 0xF, true));
                            m_ += __builtin_bit_cast(float, __builtin_amdgcn_update_dpp(0, __builtin_bit_cast(int, m_), 0x128, 0xF, 0xF, true));
                            m_ += __builtin_bit_cast(float, __builtin_amdgcn_update_dpp(0, __builtin_bit_cast(int, m_), 0x124, 0xF, 0xF, true));
                            yacc = (jq == (((u - 4) >> 2) & 3)) ? m_ : yacc;
                            if ((u & 15) == 0) yout[(size_t)(ci * CH + (u - 16)) * 512] = yacc; }
                        const float4 w = Lw[u % 3], kk = Lkk[u % 3], bb = Lbb[u % 3], rv = Lrv[u % 3], vk = Lvk[u % 3];
                        const f32x2 kk01 = {kk.x, kk.y}, kk23 = {kk.z, kk.w}, bb01 = {bb.x, bb.y}, bb23 = {bb.z, bb.w}, vk01 = {vk.x, vk.y}, vk23 = {vk.z, vk.w}, w01 = {w.x, w.y}, w23 = {w.z, w.w}, r01 = {rv.x, rv.y}, r23 = {rv.z, rv.w};
                        const f32x2 q01 = s01 * w01 + vk01, q23 = s23 * w23 + vk23;
                        f32x2 d2 = s01 * kk01; d2 = s23 * kk23 + d2;
                        float dot = d2.x + d2.y; dot = row16_sum(dot);
                        const f32x2 sa2 = {-dot, -dot};
                        s01 = sa2 * bb01 + q01;
                        s23 = sa2 * bb23 + q23;
                        f32x2 y2 = s01 * r01; y2 = s23 * r23 + y2;
                        const float ypn = y2.x + y2.y;
                        if ((u & 3) == 0) yp0 = ypn; else if ((u & 3) == 1) yp1 = ypn; else if ((u & 3) == 2) yp2 = ypn; else yp3 = ypn;
                    }
                    {
                        const float sa_ = odd1 ? yp2 : yp0, sb_ = odd1 ? yp3 : yp1, ta_ = odd1 ? yp0 : yp2, tb_ = odd1 ? yp1 : yp3;
                        const float n0 = sa_ + __builtin_bit_cast(float, __builtin_amdgcn_update_dpp(0, __builtin_bit_cast(int, ta_), 0xB1, 0xF, 0xF, true));
                        const float n1 = sb_ + __builtin_bit_cast(float, __builtin_amdgcn_update_dpp(0, __builtin_bit_cast(int, tb_), 0xB1, 0xF, 0xF, true));
                        const float sc_ = odd2 ? n1 : n0, tc_ = odd2 ? n0 : n1;
                        float m_ = sc_ + __builtin_bit_cast(float, __builtin_amdgcn_update_dpp(0, __builtin_bit_cast(int, tc_), 0x4E, 0xF, 0xF, true));
                        m_ += __builtin_bit_cast(float, __builtin_amdgcn_update_dpp(0, __builtin_bit_cast(int, m_), 0x128, 0xF, 0xF, true));
                        m_ += __builtin_bit_cast(float, __builtin_amdgcn_update_dpp(0, __builtin_bit_cast(int, m_), 0x124, 0xF, 0xF, true));
                        yacc = (jq == 3) ? m_ : yacc;
                        yout[(size_t)(ci * CH + 16) * 512] = yacc; }
#undef SC_LD
                    RING_BAR();
                }
            }
        }
    }
}

__device__ __forceinline__ float oct_sum(float x) {
    x += __builtin_bit_cast(float, __builtin_amdgcn_update_dpp(0, __builtin_bit_cast(int, x), 0xB1, 0xF, 0xF, true));
    x += __builtin_bit_cast(float, __builtin_amdgcn_update_dpp(0, __builtin_bit_cast(int, x), 0x4E, 0xF, 0xF, true));
    x += __builtin_bit_cast(float, __builtin_amdgcn_update_dpp(0, __builtin_bit_cast(int, x), 0x141, 0xF, 0xF, true));
    return x;
}
__device__ void phase_odd_post(const Ctx& P, int layer) {
    const int i = layer >> 1, tid = ltid(), lane = tid & 63;
    const bf16_t* Pb = (const bf16_t*)(P.ws + WS_P); bf16_t* YM = (bf16_t*)P.out;
    const float* SCY = (const float*)(P.ws + WS_SC + SC_Y); const float* BS = (const float*)(P.ws + WS_MISC + MS_BS);
    const float* lng = P.in[28] + i * 512; const float* lnbias = P.in[29] + i * 512;
    const int c8 = lane * 8, hd = lane >> 3;
    float gw[8], gb[8];
    { const float4 a0 = *(const float4*)(lng + c8), a1 = *(const float4*)(lng + c8 + 4), b0 = *(const float4*)(lnbias + c8), b1 = *(const float4*)(lnbias + c8 + 4);
      gw[0] = a0.x; gw[1] = a0.y; gw[2] = a0.z; gw[3] = a0.w; gw[4] = a1.x; gw[5] = a1.y; gw[6] = a1.z; gw[7] = a1.w; gb[0] = b0.x; gb[1] = b0.y; gb[2] = b0.z; gb[3] = b0.w; gb[4] = b1.x; gb[5] = b1.y; gb[6] = b1.z; gb[7] = b1.w; }
    const int tstep = lnb() * 8; int t = lbid() * 8 + (tid >> 6);
    float4 y0, y1; uint4 vr, gr; float bs;
    if (t < M_TOK) { y0 = *(const float4*)(SCY + (size_t)t * 512 + c8); y1 = *(const float4*)(SCY + (size_t)t * 512 + c8 + 4); vr = *(const uint4*)(Pb + (size_t)t * PP + 1024 + c8); gr = *(const uint4*)(YM + (size_t)t * DM + c8); bs = BS[t * 8 + hd]; }
    for (; t < M_TOK; t += tstep) {
        const int tn = t + tstep < M_TOK ? t + tstep : t;
        const float4 ny0 = *(const float4*)(SCY + (size_t)tn * 512 + c8), ny1 = *(const float4*)(SCY + (size_t)tn * 512 + c8 + 4);
        const uint4 nvr = *(const uint4*)(Pb + (size_t)tn * PP + 1024 + c8), ngr = *(const uint4*)(YM + (size_t)tn * DM + c8); const float nbs = BS[tn * 8 + hd];
        float y[8] = {y0.x, y0.y, y0.z, y0.w, y1.x, y1.y, y1.z, y1.w}, v[8], g[8]; unpack8(vr, v); unpack8(gr, g);
        float s = 0.f;
#pragma unroll
        for (int e = 0; e < 8; ++e) s += y[e];
        const float mean = oct_sum(s) * (1.0f / 64.0f);
        float q = 0.f;
#pragma unroll
        for (int e = 0; e < 8; ++e) { y[e] -= mean; q += y[e] * y[e]; }
        const float rstd = rsqrtf(oct_sum(q) * (1.0f / 64.0f) + 64e-5f);
#pragma unroll
        for (int e = 0; e < 8; ++e) y[e] = (y[e] * rstd * gw[e] + gb[e] + bs * v[e]) * g[e];
        *(uint4*)(YM + (size_t)t * DM + c8) = pack8(y);
        y0 = ny0; y1 = ny1; vr = nvr; gr = ngr; bs = nbs;
    }
}

#define XB_TMO      128
#define XB_XCNT(j)  (256  + 64 * (j))
#define XB_XSUB(j)  (1280 + 64 * (j))
#define XB_XGEN(j)  (2304 + 64 * (j))
#define XB_TOP      3328
#define XB_TOPGEN   3392
#define XCD_BAR_WORDS 3456
#define XB_SPIN_CAP (1u << 18)

__device__ __forceinline__ unsigned xb_ld(unsigned* p)              { return __hip_atomic_load(p, __ATOMIC_RELAXED, __HIP_MEMORY_SCOPE_AGENT); }
__device__ __forceinline__ unsigned xb_add(unsigned* p, unsigned v) { return __hip_atomic_fetch_add(p, v, __ATOMIC_RELAXED, __HIP_MEMORY_SCOPE_AGENT); }
__device__ __forceinline__ unsigned xb_xcc_id() { return (unsigned)__builtin_amdgcn_s_getreg((3 << 11) | 20) & 0xFu; }
#define XB_SPIN(cond, bar) do { unsigned _sp = 0; while (cond) { __builtin_amdgcn_s_sleep(1); \
    if ((++_sp & 255u) == 0u) { if (xb_ld(&(bar)[XB_TMO])) break; if (_sp > XB_SPIN_CAP) { atomicAdd(&(bar)[XB_TMO], 1u); break; } } } } while (0)

struct XcdBarrier {
    unsigned* bar; unsigned x;
    volatile LAS unsigned* st;
};

__device__ __forceinline__ XcdBarrier xcd_barrier_post(unsigned* bar, volatile LAS unsigned* st) {
    XcdBarrier b; b.bar = bar; b.x = xb_xcc_id(); b.st = st;
    if (threadIdx.x == 0) (void)xb_add(&bar[XB_XCNT(b.x)], 1u);
    return b;
}
__device__ __forceinline__ void xcd_barrier_complete(unsigned* bar, unsigned x, unsigned& nloc, unsigned& nx) {
    const unsigned G = gridDim.x * gridDim.y * gridDim.z;
    unsigned sum, cnt, mine, sp = 0u;
    for (;;) {
        sum = 0u; cnt = 0u; mine = 0u;
#pragma unroll
        for (unsigned j = 0; j < 16; ++j) { const unsigned c = xb_ld(&bar[XB_XCNT(j)]); sum += c; cnt += (c > 0u) ? 1u : 0u; mine = (j == x) ? c : mine; }
        if (sum == G) break;
        __builtin_amdgcn_s_sleep(1);
        if ((++sp & 255u) == 0u) { if (xb_ld(&bar[XB_TMO])) break; if (sp > XB_SPIN_CAP) { atomicAdd(&bar[XB_TMO], 1u); break; } }
    }
    nloc = mine > 0u ? mine : 1u; nx = cnt > 0u ? cnt : 1u;
}

__device__ __forceinline__ void xcd_barrier(const XcdBarrier& b) {
    asm volatile("s_waitcnt vmcnt(0)" ::: "memory");
    __syncthreads();
    if (threadIdx.x == 0) {
        unsigned* bar = b.bar;
        __builtin_amdgcn_s_waitcnt(0);
        unsigned nloc = b.st[0], nx = b.st[1];
        if (nloc == 0u) { xcd_barrier_complete(bar, b.x, nloc, nx); b.st[0] = nloc; b.st[1] = nx; }
        const unsigned old = xb_add(&bar[XB_XSUB(b.x)], 1u);
        const unsigned gen = old / nloc;
        if (old + 1u == (gen + 1u) * nloc) {
            __builtin_amdgcn_fence(__ATOMIC_RELEASE, "agent");
            asm volatile("s_waitcnt vmcnt(0)" ::: "memory");
            const unsigned og = xb_add(&bar[XB_TOP], 1u);
            const unsigned tg = og / nx;
            if (og + 1u == (tg + 1u) * nx) xb_add(&bar[XB_TOPGEN], 1u);
            else XB_SPIN(xb_ld(&bar[XB_TOPGEN]) == tg, bar);
            __builtin_amdgcn_fence(__ATOMIC_ACQUIRE, "agent");
            xb_add(&bar[XB_XGEN(b.x)], 1u);
            asm volatile("s_waitcnt vmcnt(0)" ::: "memory");
        } else {
            XB_SPIN(xb_ld(&bar[XB_XGEN(b.x)]) == gen, bar);
            __builtin_amdgcn_fence(__ATOMIC_ACQUIRE, "agent");
            asm volatile("s_waitcnt vmcnt(0)" ::: "memory");
        }
    }
    __syncthreads();
}

#ifndef REPEAT_ODD
#define REPEAT_ODD -1
#endif
#ifndef SUBMASK
#define SUBMASK 0x3ff
#endif
#define EN(s) (((SUBMASK) >> (s)) & 1)
#ifndef PH_ODD_FORCE
#define PH_ODD_FORCE
#endif
constexpr int N_PHASES = 41;
__host__ __device__ inline bool phase_is_noop(int ph) { return ph < 40 && ((ph / 10) & 1) && (ph % 10) == 5; }

__device__ __forceinline__ void run_phase(const Ctx& P, int ph, unsigned char* shm) {
    bf16_t* HN = (bf16_t*)(P.ws + WS_HN); bf16_t* Pb = (bf16_t*)(P.ws + WS_P); bf16_t* HB2 = (bf16_t*)(P.ws + WS_SC + SC_HB2);
    float* SS1 = (float*)(P.ws + WS_SC + SC_SSP1); float* SS2 = (float*)(P.ws + WS_SC + SC_SSP2); float* RS1 = (float*)(P.ws + WS_MISC + MS_SS1); float* RS2 = (float*)(P.ws + WS_MISC + MS_SS2);
    if (ph == 40) { phase_final_norm(HN, P.out, P.in[6], SS1); return; }
    const int layer = ph / 10, sub = ph % 10; const bool odd = (layer & 1) PH_ODD_FORCE;
#ifdef ONLY_SUB
    if (sub != ONLY_SUB) return;
#endif
    switch (sub) {
    case 0: if (EN(0)) { phase_convert(P, layer, shm); if (layer == 0) phase_x_to_bf16(P.in[0], HN, RS1); else finalize_rstd(SS1, RS1);
#ifdef FILL_PROBE
              if (layer == 0) { uint4 z; z.x = 0u; z.y = 0u; z.z = 0u; z.w = 0u; uint4* fp = (uint4*)(P.ws + WS_SC + 128 * MiB); for (size_t i_ = (size_t)lbid() * 512 + ltid(); i_ < 80 * MiB / 16; i_ += (size_t)lnb() * 512) fp[i_] = z; }
#endif
            } break;
    case 1: if (EN(1)) { pg8::Gemm g{HN, (const bf16_t*)(P.ws + WS_WIN), M_TOK, odd ? 2816 : 2560, 1024}; pg8::StaticOrder S; S.init(g.M, g.N, lnb(), lbid());
              EpiP E{Pb, odd ? (bf16_t*)(P.ws + WS_MISC + MS_BND) : nullptr, RS1}; pg8::gemm_phase<EpiP, pg8::StaticOrder>((PG8_LAS unsigned char*)shm, g, S, E, nullptr); } break;
#ifdef DRY_ODD_PREP
    case 2: if (EN(2)) { if (odd) { phase_odd_prep(P, layer, shm, true); __syncthreads(); phase_odd_prep(P, layer, shm); } else phase_even_prep(P, layer); } break;
#else
    case 2: if (EN(2)) { if (odd) phase_odd_prep(P, layer, shm); else phase_even_prep(P, layer); } break;
#endif
    case 3: if (EN(3)) { if (odd) phase_odd_scan(P, shm); else phase_even_states(P, layer, shm); } break;
    case 4: if (EN(4)) { if (odd) phase_odd_post(P, layer); else phase_even_pass(P); } break;
    case 5: if (EN(5)) { if (!odd) phase_even_out(P, layer, shm); } break;
    case 6: if (EN(6)) { pg8::Gemm g{(const bf16_t*)P.out, (const bf16_t*)(P.ws + WS_WOUT), M_TOK, 1024, 1024}; pg8::StaticOrder S; S.init(g.M, g.N, lnb(), lbid());
              EpiRes E{HN, HB2, SS2}; pg8::gemm_phase<EpiRes, pg8::StaticOrder>((PG8_LAS unsigned char*)shm, g, S, E, nullptr); } break;
    case 7: if (EN(7)) finalize_rstd(SS2, RS2); break;
    case 8: if (EN(8)) { pg8::Gemm g{HB2, (const bf16_t*)(P.ws + WS_WGU), M_TOK, 5632, 1024}; pg8::StaticOrder S; S.init(g.M, g.N, lnb(), lbid());
              EpiSwi E{Pb, RS2}; pg8::gemm_phase<EpiSwi, pg8::StaticOrder>((PG8_LAS unsigned char*)shm, g, S, E, nullptr); } break;
    case 9: if (EN(9)) {
#ifdef STAGGER_US
              if (lbid() & 4) { const unsigned long long t0_ = __builtin_amdgcn_s_memrealtime(); while (__builtin_amdgcn_s_memrealtime() - t0_ < (unsigned long long)(STAGGER_US) * 100ull) __builtin_amdgcn_s_sleep(8); }
#endif
              pg8::Gemm g{Pb, (const bf16_t*)(P.ws + WS_WDN), M_TOK, 1024, 2816}; pg8::StaticOrder S; S.init(g.M, g.N, lnb(), lbid());
              EpiRes E{HB2, HN, SS1}; pg8::gemm_phase<EpiRes, pg8::StaticOrder>((PG8_LAS unsigned char*)shm, g, S, E, nullptr); } break;
    }
}

__global__ void __launch_bounds__(512, 2) k_main(Params P) {
    extern __shared__ __attribute__((aligned(16))) unsigned char shm[];
    cg::grid_group grid = cg::this_grid();
    volatile LAS unsigned* bst = (volatile LAS unsigned*)((LAS unsigned char*)shm + LDS_BYTES - 16);
    if (threadIdx.x < 2) bst[threadIdx.x] = 0u;
    __syncthreads();
    (void)xcd_barrier_post((unsigned*)(P.ws + WS_MISC + MS_BAR), bst);
    int nsync = 0;
#define GRID_BAR() do { int zb_ = 0; asm volatile("" : "+s"(zb_)); XcdBarrier bar_; bar_.bar = (unsigned*)(P.ws + zb_ + WS_MISC + MS_BAR); bar_.x = xb_xcc_id(); \
        bar_.st = (volatile LAS unsigned*)((LAS unsigned char*)shm + LDS_BYTES - 16); xcd_barrier(bar_); } while (0)
    bool first = true;
#ifdef EXTRA_SYNCS
    for (int es_ = 0; es_ < EXTRA_SYNCS; ++es_) GRID_BAR();
#endif
    for (int ph = P.ph_lo; ph < P.ph_hi; ++ph) {
        if (phase_is_noop(ph)) continue;
        if (!first) { if (nsync == 0) grid.sync(); else GRID_BAR(); nsync = 1; }
        first = false;
        int z = 0; asm volatile("" : "+s"(z));
        Ctx C; C.in.p = &P; C.in.z = z; C.out = P.out + z; C.ws = P.ws + z;
        run_phase(C, ph, shm);
#ifdef REPEAT_MASK
        if (ph < 40 && ((REPEAT_MASK >> (ph % 10)) & 1) && (REPEAT_ODD < 0 || ((ph / 10) & 1) == REPEAT_ODD)) { GRID_BAR(); run_phase(C, ph, shm); }
#endif

    }
}

#ifndef MK_ONE_LAUNCH
#define MK_ONE_LAUNCH 1
#endif
extern "C" void kernel_launch(void* const* d_in, const int* in_sizes, int n_in, void* d_out, int out_size, void* d_ws, size_t ws_size, hipStream_t stream) {
    static int state = 0;
    if (state == 0) {
        if (n_in != NIN || out_size != M_TOK * DM || ws_size < WS_END) { fprintf(stderr, "kernel_launch: unexpected shapes (n_in %d out %d ws %zu)\n", n_in, out_size, ws_size); state = -1; return; }
        if (hipFuncSetAttribute((const void*)k_main, hipFuncAttributeMaxDynamicSharedMemorySize, LDS_BYTES) != hipSuccess) { fprintf(stderr, "kernel_launch: hipFuncSetAttribute failed\n"); state = -1; return; }
        int dev = 0, cus = 0, per_cu = 0;
        if (hipGetDevice(&dev) != hipSuccess || hipDeviceGetAttribute(&cus, hipDeviceAttributeMultiprocessorCount, dev) != hipSuccess || cus < 8) { fprintf(stderr, "kernel_launch: cannot query the CU count\n"); state = -1; return; }
        if (hipOccupancyMaxActiveBlocksPerMultiprocessor(&per_cu, (const void*)k_main, 512, LDS_BYTES) != hipSuccess || per_cu < 1) fprintf(stderr, "kernel_launch: note: occupancy query reports %d workgroups per CU\n", per_cu);
        (void)hipGetLastError();
        state = (cus < 256 ? cus : 256) & ~7;
    }
    if (state < 0) return;
    if (hipMemsetAsync((unsigned char*)d_ws + WS_MISC + MS_BAR, 0, BAR_BYTES, stream) != hipSuccess) { fprintf(stderr, "kernel_launch: memset failed\n"); return; }
    Params p{};
    for (int i = 0; i < NIN; ++i) p.in[i] = (const float*)d_in[i];
    p.out = (float*)d_out; p.ws = (unsigned char*)d_ws;
#if MK_ONE_LAUNCH
    p.ph_lo = 0; p.ph_hi = N_PHASES;
    void* args[] = {&p};
    hipError_t e = hipLaunchCooperativeKernel((const void*)k_main, dim3(state), dim3(512), args, LDS_BYTES, stream);
    if (e != hipSuccess) fprintf(stderr, "cooperative launch failed: %s\n", hipGetErrorString(e));
#else
    for (int ph = 0; ph < N_PHASES; ++ph) { if (phase_is_noop(ph)) continue; p.ph_lo = ph; p.ph_hi = ph + 1; hipLaunchKernelGGL(k_main, dim3(state), dim3(512), LDS_BYTES, stream, p); }
#endif
}
```

```cpp
#include <hip/hip_runtime.h>
#include <hip/hip_cooperative_groups.h>
#include <cstdio>
namespace cg = cooperative_groups;

typedef unsigned short bf16_t;
constexpr int M_TOK = 32768, SEQ = 16384, DM = 1024, FF = 2816, PP = 2816;
constexpr int LDS_BYTES = 163840;
constexpr int NIN = 37;

constexpr size_t MiB = 1048576;
constexpr size_t WS_WIN = 0, WS_WOUT = 5767168, WS_WGU = 7864320, WS_WDN = 19398656;
constexpr size_t WS_HN = 24 * MiB, WS_P = 88 * MiB, WS_SC = 264 * MiB, WS_MISC = 504 * MiB, WS_END = 512 * MiB;
constexpr size_t SC_XBC = 0, SC_ST = 80 * MiB, SC_CB = 176 * MiB, SC_PD = 208 * MiB;
constexpr size_t SC_W = 0, SC_KK = 64 * MiB, SC_B = 96 * MiB, SC_Y = 128 * MiB;
constexpr size_t MS_BND = 0, MS_AGG = 4325376, MS_BS = MS_AGG + 1048576, MS_CDEC = MS_BS + 1048576, MS_BAR = MS_CDEC + 12288, BAR_BYTES = 3456 * 4, MS_SS1 = MS_BAR + BAR_BYTES, MS_SS2 = MS_SS1 + 131072;
constexpr size_t SC_HB2 = 0, SC_SSP2 = 64 * MiB, SC_SSP1 = 66 * MiB;
__device__ __forceinline__ float row_rstd(const float* ssp, int row) { const float4* p = (const float4*)(ssp + (size_t)row * 16); const float4 a = p[0], b = p[1], c = p[2], d = p[3];
    const float s = ((a.x + a.y) + (a.z + a.w)) + ((b.x + b.y) + (b.z + b.w)) + ((c.x + c.y) + (c.z + c.w)) + ((d.x + d.y) + (d.z + d.w)); return rsqrtf(s * (1.0f / 1024.0f) + 1e-6f); }
constexpr size_t SC_UNUSED_ = 0;

#define LAS __attribute__((address_space(3)))
struct Params { const float* in[NIN]; float* out; unsigned char* ws; int ph_lo, ph_hi; };
struct InArr { const Params* p; int z; __device__ __forceinline__ const float* operator[](int k) const { return p->in[k + z]; } };
struct Ctx { InArr in; float* out; unsigned char* ws; };

__device__ __forceinline__ int ltid() { int t = threadIdx.x; asm volatile("" : "+v"(t)); return t; }
__device__ __forceinline__ int lbid() { int t = blockIdx.x; asm volatile("" : "+s"(t)); return t; }
__device__ __forceinline__ int lnb() { int t = gridDim.x; asm volatile("" : "+s"(t)); return t; }
__device__ __forceinline__ float bf2f(bf16_t b) { return __uint_as_float(((unsigned)b) << 16); }
typedef __bf16 bf16x2_nat __attribute__((ext_vector_type(2)));
__device__ __forceinline__ unsigned pack2(float lo, float hi) { bf16x2_nat v; v.x = (__bf16)lo; v.y = (__bf16)hi; return __builtin_bit_cast(unsigned, v); }
__device__ __forceinline__ bf16_t f2bf(float f) { return __builtin_bit_cast(bf16_t, (__bf16)f); }
__device__ __forceinline__ float wave_sum(float v) {
#pragma unroll
    for (int o = 32; o >= 1; o >>= 1) v += __shfl_xor(v, o);
    return v;
}
__device__ __forceinline__ float rcpf_(float x) { return __builtin_amdgcn_rcpf(x); }
__device__ __forceinline__ float sigmoidf_(float x) { return rcpf_(1.0f + __expf(-x)); }
__device__ __forceinline__ float siluf_(float x) { return x * rcpf_(1.0f + __expf(-x)); }
__device__ __forceinline__ float softplusf_(float x) { return fmaxf(x, 0.0f) + __logf(1.0f + __expf(-fabsf(x))); }
__device__ __forceinline__ float tanhf_(float x) { return 1.0f - 2.0f * rcpf_(1.0f + __expf(2.0f * x)); }
__device__ __forceinline__ float gelu_tanh_(float x) { const float u = 0.7978845608028654f * (x + 0.044715f * x * x * x); return 0.5f * x * (1.0f + tanhf_(u)); }
__device__ __forceinline__ float row16_sum(float x) {
    x += __builtin_bit_cast(float, __builtin_amdgcn_update_dpp(0, __builtin_bit_cast(int, x), 0xB1, 0xF, 0xF, true));
    x += __builtin_bit_cast(float, __builtin_amdgcn_update_dpp(0, __builtin_bit_cast(int, x), 0x4E, 0xF, 0xF, true));
    x += __builtin_bit_cast(float, __builtin_amdgcn_update_dpp(0, __builtin_bit_cast(int, x), 0x141, 0xF, 0xF, true));
    x += __builtin_bit_cast(float, __builtin_amdgcn_update_dpp(0, __builtin_bit_cast(int, x), 0x140, 0xF, 0xF, true));
    return x;
}
__device__ __forceinline__ float bflo(unsigned w) { return __uint_as_float(w << 16); }
__device__ __forceinline__ float bfhi(unsigned w) { return __uint_as_float(w & 0xffff0000u); }
typedef short bf16x8_t __attribute__((ext_vector_type(8)));
typedef float f32x16_t __attribute__((ext_vector_type(16)));
__device__ __forceinline__ uint4 pack8(const float* v) { uint4 o; o.x = pack2(v[0], v[1]); o.y = pack2(v[2], v[3]); o.z = pack2(v[4], v[5]); o.w = pack2(v[6], v[7]); return o; }
__device__ __forceinline__ void unpack8(const uint4 r, float* v) { v[0] = bflo(r.x); v[1] = bfhi(r.x); v[2] = bflo(r.y); v[3] = bfhi(r.y); v[4] = bflo(r.z); v[5] = bfhi(r.z); v[6] = bflo(r.w); v[7] = bfhi(r.w); }
__device__ __forceinline__ float half32_sum(float x) { x = row16_sum(x); return x + __shfl_xor(x, 16); }

namespace pg8 {
#define PG8_LAS __attribute__((address_space(3)))
typedef unsigned short bf16_t;
typedef short bf16x8 __attribute__((ext_vector_type(8)));
typedef float f32x4 __attribute__((ext_vector_type(4)));
typedef unsigned u32x4 __attribute__((ext_vector_type(4)));
constexpr int BM = 256, BK = 64, HALF = 128, HTB = HALF * BK * 2  , STAGE_BYTES = 8 * HTB, NXCD = 8, WGM = 8;

__host__ __device__ __forceinline__ int lds_byte(int r, int c) { const int st = (r >> 4) * 2 + (c >> 5), rr = r & 15, cc = c & 31, ob = rr * 64 + cc * 2; return st * 1024 + (ob ^ (((ob >> 9) & 1) << 5)); }
__host__ __device__ __forceinline__ void stage_rc(int b, int& R, int& C) { const int st = b / 1024, sb = b % 1024, swz = sb ^ (((sb >> 9) & 1) << 5); R = (st >> 1) * 16 + swz / 64; C = (st & 1) * 32 + (swz % 64) / 2; }
__host__ __device__ __forceinline__ int perm32(int rho) { const int n = rho >> 4, i = rho & 15; return 8 * (i >> 2) + 4 * n + (i & 3); }

struct Unit { int pm, pn; };
struct Gemm { const bf16_t* A; const bf16_t* Bt; int M, N, K; };

struct StaticOrder {
    int nM, nN, nwg, G, c;
    __host__ __device__ void init(int M, int N, int G_, int c_) { nM = M / BM; nN = N / BM; nwg = nM * nN; G = G_; c = c_; }
    __host__ __device__ bool next(int i, Unit& u) const {
        const long L = (long)i * G + c; if (L >= nwg) return false;
        int wgid = (int)L; { const int q = nwg / NXCD, r = nwg % NXCD, xcd = wgid % NXCD, off = wgid / NXCD; wgid = (xcd < r ? xcd * (q + 1) : r * (q + 1) + (xcd - r) * q) + off; }
        const int nig = WGM * nN, gid = wgid / nig, fm = gid * WGM, gsz = (nM - fm) < WGM ? (nM - fm) : WGM;
        u.pm = fm + ((wgid % nig) % gsz); u.pn = (wgid % nig) / gsz; return true;
    }
    __device__ __forceinline__ void a_ready(const Unit&) const {}
    __device__ __forceinline__ void done(const Unit&) const {}
};
__device__ __forceinline__ unsigned cvt_pk_bf16(float lo, float hi) { unsigned r; asm volatile("v_cvt_pk_bf16_f32 %0, %1, %2" : "=v"(r) : "v"(lo), "v"(hi)); return r; }
typedef float f32x2 __attribute__((ext_vector_type(2)));
template <class Epi, class Sched, bool STAMP = false>
__device__ __forceinline__ void gemm_phase(PG8_LAS unsigned char* lds, const Gemm g, const Sched& S, const Epi& E, unsigned long long* stamps) {
    const int tid = ltid(), wid = __builtin_amdgcn_readfirstlane(tid >> 6), lane = tid & 63, wr = wid >> 2, wc = wid & 3, fr = lane & 15, fq = lane >> 4;
    const int K = g.K, nt = K / BK;
    int ts_lo = 0, ts_hi = 0, nts = 0; const unsigned long long rt_entry = STAMP ? (unsigned long long)wall_clock64() : 0ull;
#define PG8_STAMP() do { if (STAMP && wid == 0 && nts < 64) { const unsigned long long _c = (unsigned long long)clock64(); \
        ts_lo = (lane == nts) ? (int)(unsigned)_c : ts_lo; ts_hi = (lane == nts) ? (int)(unsigned)(_c >> 32) : ts_hi; ++nts; } } while (0)
    PG8_STAMP();
    unsigned voffA[2], voffB[2];
#pragma unroll
    for (int i = 0; i < 2; ++i) { int R, C; stage_rc(tid * 16 + i * 8192, R, C); const int Rb = Epi::PERM ? ((R & ~31) + perm32(R & 31)) : R;
        voffA[i] = (unsigned)(R * K + C) * 2u; voffB[i] = (unsigned)(Rb * K + C) * 2u; }
    const size_t kstep = (size_t)(BK * 2);
    const size_t hstep = (size_t)HALF * K * 2;
    const size_t tstep = 2 * hstep;
    const unsigned ldsw = (unsigned)wid * 1024u;
    const int aoff = lds_byte(wr * 64 + fr, fq * 8), boff = lds_byte(wc * 32 + fr, fq * 8);
#define PG8_SA(b, h) (((b) * 2 + (h)) * HTB)
#define PG8_SB(b, h) ((4 + (b) * 2 + (h)) * HTB)
#define PG8_STAGE(bufoff, gbase, voff) do { _Pragma("unroll") for (int _i = 0; _i < 2; ++_i) \
        __builtin_amdgcn_global_load_lds((const unsigned*)((const char*)(gbase) + (voff)[_i]), (PG8_LAS unsigned*)(lds + (bufoff) + ldsw + _i * 8192), 16, 0, 0); } while (0)
#define PG8_LDA(dst, b, h) do { _Pragma("unroll") for (int m = 0; m < 4; ++m) _Pragma("unroll") for (int k = 0; k < 2; ++k) dst[m][k] = *(const PG8_LAS bf16x8*)(lds + PG8_SA(b, h) + aoff + m * 2048 + k * 1024); } while (0)
#define PG8_LDB(dst, b, h) do { _Pragma("unroll") for (int n = 0; n < 2; ++n) _Pragma("unroll") for (int k = 0; k < 2; ++k) dst[n][k] = *(const PG8_LAS bf16x8*)(lds + PG8_SB(b, h) + boff + n * 2048 + k * 1024); } while (0)
#define PG8_MMA(ai, bj, At, Bt) do { __builtin_amdgcn_s_setprio(1); _Pragma("unroll") for (int m = 0; m < 4; ++m) _Pragma("unroll") for (int n = 0; n < 2; ++n) _Pragma("unroll") for (int k = 0; k < 2; ++k) \
        acc[ai][bj][m][n] = __builtin_amdgcn_mfma_f32_16x16x32_bf16(Bt[n][k], At[m][k], acc[ai][bj][m][n], 0, 0, 0); __builtin_amdgcn_s_setprio(0); } while (0)
#define PG8_WAIT_V(n) asm volatile("s_waitcnt vmcnt(" #n ")" ::: "memory")
#define PG8_WAIT_L(n) asm volatile("s_waitcnt lgkmcnt(" #n ")" ::: "memory")
#define PG8_BAR __builtin_amdgcn_s_barrier()
#define PG8_SCHED __builtin_amdgcn_sched_barrier(0)
    Unit cur, nxt; int ui = 0;
    if (!S.next(0, cur)) return;
    f32x4 acc[2][2][4][2];
#pragma unroll
    for (int a = 0; a < 2; ++a)
#pragma unroll
        for (int b = 0; b < 2; ++b)
#pragma unroll
            for (int m = 0; m < 4; ++m)
#pragma unroll
                for (int n = 0; n < 2; ++n) acc[a][b][m][n] = (f32x4){0.f, 0.f, 0.f, 0.f};
    bf16x8 At[4][2], B0[2][2], B1[2][2];
    const char* cA = (const char*)g.A + (size_t)cur.pm * tstep; const char* cB = (const char*)g.Bt + (size_t)cur.pn * tstep;
    S.a_ready(cur);
    PG8_STAGE(PG8_SB(0, 0), cB, voffB); PG8_STAGE(PG8_SA(0, 0), cA, voffA); PG8_STAGE(PG8_SB(0, 1), cB + hstep, voffB); PG8_STAGE(PG8_SA(0, 1), cA + hstep, voffA);
    if (wr == 1) PG8_BAR;
    PG8_WAIT_V(4); PG8_BAR;
    PG8_STAGE(PG8_SB(1, 0), cB + kstep, voffB); PG8_STAGE(PG8_SA(1, 0), cA + kstep, voffA); PG8_STAGE(PG8_SB(1, 1), cB + hstep + kstep, voffB);
    PG8_WAIT_V(6); PG8_BAR;
    PG8_STAMP();
    for (;;) {
        const bool has_next = S.next(ui + 1, nxt);
        const char* nA = has_next ? (const char*)g.A + (size_t)nxt.pm * tstep : cA; const char* nB = has_next ? (const char*)g.Bt + (size_t)nxt.pn * tstep : cB;
        for (int t = 0; t < nt; t += 2) {
            const bool last = (t == nt - 2);
            const char* a1 = cA + (size_t)(t + 1) * kstep;
            const char* a2 = last ? nA : cA + (size_t)(t + 2) * kstep; const char* b2 = last ? nB : cB + (size_t)(t + 2) * kstep;
            const char* a3 = a2 + kstep; const char* b3 = b2 + kstep;
            if (last && has_next) S.a_ready(nxt);
            PG8_LDB(B0, 0, 0); PG8_SCHED; PG8_LDA(At, 0, 0); PG8_STAGE(PG8_SA(1, 1), a1 + hstep, voffA);
            PG8_WAIT_L(8); PG8_BAR; PG8_WAIT_L(0); PG8_MMA(0, 0, At, B0); PG8_BAR; PG8_SCHED;
            PG8_LDB(B1, 0, 1); PG8_STAGE(PG8_SB(0, 0), b2, voffB);
            PG8_BAR; PG8_WAIT_L(0); PG8_MMA(0, 1, At, B1); PG8_BAR;
            PG8_LDA(At, 0, 1); PG8_STAGE(PG8_SA(0, 0), a2, voffA);
            PG8_BAR; PG8_WAIT_L(0); PG8_MMA(1, 0, At, B0); PG8_BAR; PG8_SCHED;
            PG8_STAGE(PG8_SB(0, 1), b2 + hstep, voffB);
            PG8_WAIT_V(6); PG8_BAR; PG8_MMA(1, 1, At, B1); PG8_BAR;
            PG8_LDB(B0, 1, 0); PG8_SCHED; PG8_LDA(At, 1, 0); PG8_STAGE(PG8_SA(0, 1), a2 + hstep, voffA);
            PG8_WAIT_L(8); PG8_BAR; PG8_WAIT_L(0); PG8_MMA(0, 0, At, B0); PG8_BAR; PG8_SCHED;
            PG8_LDB(B1, 1, 1); PG8_STAGE(PG8_SB(1, 0), b3, voffB);
            PG8_BAR; PG8_WAIT_L(0); PG8_MMA(0, 1, At, B1); PG8_BAR;
            PG8_LDA(At, 1, 1); PG8_STAGE(PG8_SA(1, 0), a3, voffA);
            PG8_BAR; PG8_WAIT_L(0); PG8_MMA(1, 0, At, B0); PG8_BAR; PG8_SCHED;
            PG8_STAGE(PG8_SB(1, 1), b3 + hstep, voffB);
            PG8_WAIT_V(6); PG8_BAR; PG8_MMA(1, 1, At, B1); PG8_BAR;
        }
        PG8_STAMP();
        if constexpr (!Epi::AFTER_DRAIN) { E(acc, cur, wr, wc, fr, fq); S.done(cur); }
        PG8_STAMP();
        if (!has_next) break;
#pragma unroll
        for (int a = 0; a < 2; ++a)
#pragma unroll
            for (int b = 0; b < 2; ++b)
#pragma unroll
                for (int m = 0; m < 4; ++m)
#pragma unroll
                    for (int n = 0; n < 2; ++n) acc[a][b][m][n] = (f32x4){0.f, 0.f, 0.f, 0.f};
        cur = nxt; cA = nA; cB = nB; ++ui;
    }
    PG8_WAIT_V(0);
    if (wr == 0) PG8_BAR;
    PG8_BAR;
    if constexpr (Epi::AFTER_DRAIN) { E.fused(acc, cur, wr, wc, fr, fq, lds, wid, lane); S.done(cur); }
    PG8_STAMP();
    if (STAMP && wid == 0) { stamps[lane] = lane < nts ? (((unsigned long long)(unsigned)ts_hi << 32) | (unsigned)ts_lo) : 0ull;
        if (lane == 62) stamps[62] = rt_entry; if (lane == 63) stamps[63] = (unsigned long long)wall_clock64(); }
#undef PG8_STAMP
#undef PG8_SA
#undef PG8_SB
#undef PG8_STAGE
#undef PG8_LDA
#undef PG8_LDB
#undef PG8_MMA
#undef PG8_WAIT_V
#undef PG8_WAIT_L
#undef PG8_BAR
#undef PG8_SCHED
}
}

typedef unsigned u32x4_t __attribute__((ext_vector_type(4)));
typedef unsigned u32x2_t __attribute__((ext_vector_type(2)));
struct EpiP {
    static constexpr bool PERM = true, AFTER_DRAIN = false;
    bf16_t* O; bf16_t* bnd; const float* ss;
    __device__ __forceinline__ void operator()(const pg8::f32x4 (&acc)[2][2][4][2], const pg8::Unit& u, int wr, int wc, int fr, int fq) const {
        const int row0 = u.pm * 256 + wr * 64 + fr, col0 = u.pn * 256 + wc * 32 + 8 * fq;
        float rsv[2][4];
#pragma unroll
        for (int ai = 0; ai < 2; ++ai)
#pragma unroll
            for (int m = 0; m < 4; ++m) rsv[ai][m] = ss[row0 + ai * 128 + m * 16];
#pragma unroll
        for (int ai = 0; ai < 2; ++ai)
#pragma unroll
            for (int m = 0; m < 4; ++m) { const int row = row0 + ai * 128 + m * 16; bf16_t* rowp = O + (size_t)row * PP + col0; const float rs = rsv[ai][m];
#pragma unroll
                for (int bj = 0; bj < 2; ++bj) { const pg8::f32x4 v0 = acc[ai][bj][m][0] * rs, v1 = acc[ai][bj][m][1] * rs;
                    u32x4_t w; w.x = pack2(v0[0], v0[1]); w.y = pack2(v0[2], v0[3]); w.z = pack2(v1[0], v1[1]); w.w = pack2(v1[2], v1[3]);
                    *(u32x4_t*)(rowp + bj * 128) = w;
                    if (bnd && (row & 127) >= 125) *(u32x4_t*)(bnd + ((size_t)(row >> 7) * 3 + (row & 127) - 125) * PP + col0 + bj * 128) = w; } }
    }
};
struct EpiRes {
    static constexpr bool PERM = true, AFTER_DRAIN = false;
    const bf16_t* hin; bf16_t* hout; float* ss;
    __device__ __forceinline__ void operator()(const pg8::f32x4 (&acc)[2][2][4][2], const pg8::Unit& u, int wr, int wc, int fr, int fq) const {
        const int row0 = u.pm * 256 + wr * 64 + fr, col0 = u.pn * 256 + wc * 32 + 8 * fq;
#pragma unroll
        for (int ai = 0; ai < 2; ++ai) {
            u32x4_t bv[4][2];
#pragma unroll
            for (int m = 0; m < 4; ++m)
#pragma unroll
                for (int bj = 0; bj < 2; ++bj) bv[m][bj] = *(const u32x4_t*)(hin + (size_t)(row0 + ai * 128 + m * 16) * DM + col0 + bj * 128);
#pragma unroll
            for (int m = 0; m < 4; ++m) { const int row = row0 + ai * 128 + m * 16; float sq = 0.f;
#pragma unroll
                for (int bj = 0; bj < 2; ++bj) { const u32x4_t r = bv[m][bj]; const pg8::f32x4 a0 = acc[ai][bj][m][0], a1 = acc[ai][bj][m][1];
                    const float v0 = bflo(r.x) + a0[0], v1 = bfhi(r.x) + a0[1], v2 = bflo(r.y) + a0[2], v3 = bfhi(r.y) + a0[3], v4 = bflo(r.z) + a1[0], v5 = bfhi(r.z) + a1[1], v6 = bflo(r.w) + a1[2], v7 = bfhi(r.w) + a1[3];
                    u32x4_t w; w.x = pack2(v0, v1); w.y = pack2(v2, v3); w.z = pack2(v4, v5); w.w = pack2(v6, v7);
                    *(u32x4_t*)(hout + (size_t)row * DM + col0 + bj * 128) = w;
                    sq += (v0 * v0 + v1 * v1) + (v2 * v2 + v3 * v3) + (v4 * v4 + v5 * v5) + (v6 * v6 + v7 * v7); }
                sq += __shfl_xor(sq, 16); sq += __shfl_xor(sq, 32);
                if (fq == 0) ss[(size_t)row * 16 + u.pn * 4 + wc] = sq; }
            asm volatile("" ::: "memory"); }
    }
};
struct EpiSwi {
    static constexpr bool PERM = true, AFTER_DRAIN = false;
    bf16_t* O; const float* ss;
    __device__ __forceinline__ void operator()(const pg8::f32x4 (&acc)[2][2][4][2], const pg8::Unit& u, int wr, int wc, int fr, int fq) const {
        const int row0 = u.pm * 256 + wr * 64 + fr, col0 = u.pn * 256 + wc * 32 + 8 * fq;
        float rsv[2][4];
#pragma unroll
        for (int ai = 0; ai < 2; ++ai)
#pragma unroll
            for (int m = 0; m < 4; ++m) rsv[ai][m] = ss[row0 + ai * 128 + m * 16];
#pragma unroll
        for (int ai = 0; ai < 2; ++ai)
#pragma unroll
            for (int m = 0; m < 4; ++m) { const int row = row0 + ai * 128 + m * 16; bf16_t* rowp = O + (size_t)row * PP + (col0 >> 1); const float rs = rsv[ai][m];
#pragma unroll
                for (int bj = 0; bj < 2; ++bj) { const pg8::f32x4 g = acc[ai][bj][m][0] * rs, up = acc[ai][bj][m][1] * rs;
                    u32x2_t w; w.x = pack2(siluf_(g[0]) * up[0], siluf_(g[1]) * up[1]); w.y = pack2(siluf_(g[2]) * up[2], siluf_(g[3]) * up[3]);
                    *(u32x2_t*)(rowp + bj * 64) = w; } }
    }
};

struct ColSrc { const float* p; int ld; };
__device__ __forceinline__ ColSrc col_src(const Ctx& P, int layer, int mat, int r) {
    const int i = layer >> 1; const bool odd = layer & 1;
    ColSrc c; c.p = nullptr; c.ld = 0;
    if (mat == 0) { if (odd) { c.p = P.in[17] + (size_t)i * 1024 * 2816 + r; c.ld = 2816; } else if (r < 2316) { c.p = P.in[7] + (size_t)i * 1024 * 2316 + r; c.ld = 2316; } }
    else if (mat == 1) { c.p = (odd ? P.in[18] : P.in[8]) + (size_t)i * 1024 * 1024 + r; c.ld = 1024; }
    else if (mat == 2) { const int q = r >> 3, j = r & 7, f = 4 * q + (j & 3); c.p = (j < 4 ? P.in[3] : P.in[4]) + (size_t)layer * 1024 * 2816 + f; c.ld = 2816; }
    else { c.p = P.in[5] + (size_t)layer * 2816 * 1024 + r; c.ld = 1024; }
    return c;
}
struct ConvTile { int mat, rt, kt, K; bf16_t* dst; };
__device__ __forceinline__ ConvTile conv_tile(const Ctx& P, int tile, int n0, int n1, int n2) {
    ConvTile c;
    if (tile < n0) { c.mat = 0; c.K = 1024; c.rt = tile / 16; c.kt = tile % 16; c.dst = (bf16_t*)(P.ws + WS_WIN); }
    else if (tile < n0 + n1) { const int x = tile - n0; c.mat = 1; c.K = 1024; c.rt = x / 16; c.kt = x % 16; c.dst = (bf16_t*)(P.ws + WS_WOUT); }
    else if (tile < n0 + n1 + n2) { const int x = tile - n0 - n1; c.mat = 2; c.K = 1024; c.rt = x / 16; c.kt = x % 16; c.dst = (bf16_t*)(P.ws + WS_WGU); }
    else { const int x = tile - n0 - n1 - n2; c.mat = 3; c.K = 2816; c.rt = x / 44; c.kt = x % 44; c.dst = (bf16_t*)(P.ws + WS_WDN); }
    return c;
}
__device__ void phase_convert(const Ctx& P, int layer, unsigned char* shm) {
    float* T = (float*)shm;
    const bool odd = layer & 1; const int n0 = (odd ? 44 : 40) * 16, n1 = 256, n2 = 88 * 16, n3 = 16 * 44, ntot = n0 + n1 + n2 + n3;
    const int tid = ltid(), nblk = lnb();
    const int rr = tid & 63, kk = tid >> 6, r2 = tid >> 3, kq = tid & 7;
    for (int tile = lbid(); tile < ntot; tile += 2 * nblk) {
        const int tile2 = tile + nblk; const bool has2 = tile2 < ntot;
        const ConvTile c0 = conv_tile(P, tile, n0, n1, n2), c1 = conv_tile(P, has2 ? tile2 : tile, n0, n1, n2);
        const ColSrc s0 = col_src(P, layer, c0.mat, c0.rt * 64 + rr), s1 = col_src(P, layer, c1.mat, c1.rt * 64 + rr);
        const float* g0 = c0.mat == 0 ? P.in[1] + layer * DM : (c0.mat == 2 ? P.in[2] + layer * DM : nullptr);
        const float* g1 = c1.mat == 0 ? P.in[1] + layer * DM : (c1.mat == 2 ? P.in[2] + layer * DM : nullptr);
        float v0[8], v1[8];
#pragma unroll
        for (int k8 = 0; k8 < 8; ++k8) { const int k = k8 * 8 + kk;
            v0[k8] = s0.p ? s0.p[(size_t)(c0.kt * 64 + k) * s0.ld] * (g0 ? g0[c0.kt * 64 + k] : 1.0f) : 0.f;
            v1[k8] = s1.p ? s1.p[(size_t)(c1.kt * 64 + k) * s1.ld] * (g1 ? g1[c1.kt * 64 + k] : 1.0f) : 0.f; }
#pragma unroll
        for (int k8 = 0; k8 < 8; ++k8) { const int k = k8 * 8 + kk; T[k * 65 + rr] = v0[k8]; T[4160 + k * 65 + rr] = v1[k8]; }
        __syncthreads();
#pragma unroll
        for (int h2 = 0; h2 < 2; ++h2) { if (h2 == 1 && !has2) break; const int cK = h2 ? c1.K : c0.K, crt = h2 ? c1.rt : c0.rt, ckt = h2 ? c1.kt : c0.kt; bf16_t* cdst = h2 ? c1.dst : c0.dst; const float* Tt = T + h2 * 4160;
            uint4 w;
            w.x = pack2(Tt[(kq * 8 + 0) * 65 + r2], Tt[(kq * 8 + 1) * 65 + r2]); w.y = pack2(Tt[(kq * 8 + 2) * 65 + r2], Tt[(kq * 8 + 3) * 65 + r2]);
            w.z = pack2(Tt[(kq * 8 + 4) * 65 + r2], Tt[(kq * 8 + 5) * 65 + r2]); w.w = pack2(Tt[(kq * 8 + 6) * 65 + r2], Tt[(kq * 8 + 7) * 65 + r2]);
            *(uint4*)(cdst + (size_t)(crt * 64 + r2) * cK + ckt * 64 + kq * 8) = w; }
        __syncthreads();
    }
}

__device__ void phase_x_to_bf16(const float* h, bf16_t* out, float* ss) {
    const int lane = ltid() & 63, gw = lbid() * 8 + (ltid() >> 6), nw = lnb() * 8;
    for (int row = gw * 2; row < M_TOK; row += nw * 2) {
        const float4* p = (const float4*)(h + (size_t)row * DM);
        float4 v[8]; float s0 = 0.f, s1 = 0.f;
#pragma unroll
        for (int i = 0; i < 8; ++i) v[i] = p[lane + 64 * i];
#pragma unroll
        for (int i = 0; i < 4; ++i) { s0 += v[i].x * v[i].x + v[i].y * v[i].y + v[i].z * v[i].z + v[i].w * v[i].w; s1 += v[4 + i].x * v[4 + i].x + v[4 + i].y * v[4 + i].y + v[4 + i].z * v[4 + i].z + v[4 + i].w * v[4 + i].w; }
        s0 = wave_sum(s0); s1 = wave_sum(s1);
        if (lane == 0) { ss[row] = rsqrtf(s0 * (1.0f / 1024.0f) + 1e-6f); ss[row + 1] = rsqrtf(s1 * (1.0f / 1024.0f) + 1e-6f); }
#pragma unroll
        for (int i = 0; i < 8; ++i) { uint2 w; w.x = pack2(v[i].x, v[i].y); w.y = pack2(v[i].z, v[i].w); *(uint2*)(out + (size_t)row * DM + (lane + 64 * i) * 4) = w; }
    }
}
__device__ void phase_final_norm(const bf16_t* h, float* out, const float* g, const float* ss) {
    const int lane = ltid() & 63, gw = lbid() * 8 + (ltid() >> 6), nw = lnb() * 8;
    for (int row = gw * 2; row < M_TOK; row += nw * 2) {
        const float rs0 = row_rstd(ss, row), rs1 = row_rstd(ss, row + 1);
        uint4 hv[4];
#pragma unroll
        for (int i = 0; i < 4; ++i) hv[i] = *(const uint4*)(h + (size_t)row * DM + (lane + 64 * i) * 8);
#pragma unroll
        for (int i = 0; i < 4; ++i) { const int c8 = (lane + 64 * (i & 1)) * 8; float v[8]; unpack8(hv[i], v); const float rs = i < 2 ? rs0 : rs1;
            const float4 g0 = *(const float4*)(g + c8), g1 = *(const float4*)(g + c8 + 4); float4 o0, o1;
            o0.x = v[0] * rs * g0.x; o0.y = v[1] * rs * g0.y; o0.z = v[2] * rs * g0.z; o0.w = v[3] * rs * g0.w; o1.x = v[4] * rs * g1.x; o1.y = v[5] * rs * g1.y; o1.z = v[6] * rs * g1.z; o1.w = v[7] * rs * g1.w;
            float* op = out + (size_t)(row + (i >> 1)) * DM + c8; *(float4*)op = o0; *(float4*)(op + 4) = o1; }
    }
}
__device__ void finalize_rstd(const float* ssp, float* rstd) { for (int i = lbid() * 512 + ltid(); i < M_TOK; i += lnb() * 512) rstd[i] = row_rstd(ssp, i); }

__device__ __forceinline__ float* tokaux(bf16_t* Pb, int t) { return (float*)(Pb + (size_t)t * PP + 2560); }

__device__ void phase_even_prep(const Ctx& P, int layer) {
    const int i = layer >> 1;
    bf16_t* Pb = (bf16_t*)(P.ws + WS_P);
    bf16_t* XBC = (bf16_t*)(P.ws + WS_SC + SC_XBC);
    float* PD = (float*)(P.ws + WS_SC + SC_PD);
    const float* cw = P.in[11] + (size_t)i * 4 * 1280; const float* cb = P.in[12] + i * 1280; const float* dtb = P.in[13] + i * 12;
    const int gt = lbid() * 512 + ltid(), gs = lnb() * 512;
    for (int idx = gt; idx < 160 * 1024; idx += gs) {
        const int cg = idx % 160, run = idx / 160, c8 = cg * 8, tstart = run * 32;
        float wk[4][8], bias[8];
#pragma unroll
        for (int k = 0; k < 4; ++k) { const float4 a = *(const float4*)(cw + k * 1280 + c8), c = *(const float4*)(cw + k * 1280 + c8 + 4); wk[k][0] = a.x; wk[k][1] = a.y; wk[k][2] = a.z; wk[k][3] = a.w; wk[k][4] = c.x; wk[k][5] = c.y; wk[k][6] = c.z; wk[k][7] = c.w; }
        { const float4 a = *(const float4*)(cb + c8), c = *(const float4*)(cb + c8 + 4); bias[0] = a.x; bias[1] = a.y; bias[2] = a.z; bias[3] = a.w; bias[4] = c.x; bias[5] = c.y; bias[6] = c.z; bias[7] = c.w; }
        float h1[8], h2[8], h3[8];
        { const bool first = (tstart & (SEQ - 1)) == 0; const int back = first ? 0 : 1;
          const uint4 r1 = *(const uint4*)(Pb + (size_t)(tstart - back) * PP + 1024 + c8), r2 = *(const uint4*)(Pb + (size_t)(tstart - 2 * back) * PP + 1024 + c8), r3 = *(const uint4*)(Pb + (size_t)(tstart - 3 * back) * PP + 1024 + c8);
          unpack8(r1, h1); unpack8(r2, h2); unpack8(r3, h3);
          const float keep = first ? 0.f : 1.f;
#pragma unroll
          for (int j = 0; j < 8; ++j) { h1[j] *= keep; h2[j] *= keep; h3[j] *= keep; } }
#pragma unroll
        for (int tb = 0; tb < 32; tb += 8) {
            uint4 raw[8];
#pragma unroll
            for (int q = 0; q < 8; ++q) raw[q] = *(const uint4*)(Pb + (size_t)(tstart + tb + q) * PP + 1024 + c8);
#pragma unroll
            for (int q = 0; q < 8; ++q) { float x[8], o[8]; unpack8(raw[q], x);
#pragma unroll
                for (int j = 0; j < 8; ++j) { o[j] = siluf_(bias[j] + wk[0][j] * h3[j] + wk[1][j] * h2[j] + wk[2][j] * h1[j] + wk[3][j] * x[j]); h3[j] = h2[j]; h2[j] = h1[j]; h1[j] = x[j]; }
                *(uint4*)(XBC + (size_t)(tstart + tb + q) * 1280 + c8) = pack8(o); }
        }
    }
    for (int idx = gt; idx < M_TOK * 12; idx += gs) { const int t = idx / 12, e = idx % 12; tokaux(Pb, t)[e] = softplusf_(bf2f(Pb[(size_t)t * PP + 2304 + e]) + dtb[e]); }
    for (int idx = gt; idx < M_TOK * 32; idx += gs) {
        const int t = idx >> 5, c8 = (idx & 31) * 8, g = c8 >> 6, w = 2 << g, tp = t & (SEQ - 1), cnt = (tp + 1 < w) ? tp + 1 : w;
        float s[8], u[8];
#pragma unroll
        for (int j = 0; j < 8; ++j) { s[j] = 0.f; u[j] = 0.f; }
        uint4 rw[16];
#pragma unroll
        for (int q = 0; q < 16; ++q) { const int qq = q < cnt ? q : 0; rw[q] = *(const uint4*)(Pb + (size_t)(t - qq) * PP + c8); }
#pragma unroll
        for (int q = 0; q < 16; ++q) { const uint4 raw = rw[q]; const float m = q < cnt ? 1.0f : 0.0f;
            const float v0 = bflo(raw.x), v1 = bfhi(raw.x), v2 = bflo(raw.y), v3 = bfhi(raw.y), v4 = bflo(raw.z), v5 = bfhi(raw.z), v6 = bflo(raw.w), v7 = bfhi(raw.w);
            s[0] += m * v0; s[1] += m * v1; s[2] += m * v2; s[3] += m * v3; s[4] += m * v4; s[5] += m * v5; s[6] += m * v6; s[7] += m * v7;
            if (q == 0) { u[0] = v0; u[1] = v1; u[2] = v2; u[3] = v3; u[4] = v4; u[5] = v5; u[6] = v6; u[7] = v7; } }
        const float inv = 1.0f / (float)cnt;
        float4 d0, d1; d0.x = s[0] * inv - u[0]; d0.y = s[1] * inv - u[1]; d0.z = s[2] * inv - u[2]; d0.w = s[3] * inv - u[3]; d1.x = s[4] * inv - u[4]; d1.y = s[5] * inv - u[5]; d1.z = s[6] * inv - u[6]; d1.w = s[7] * inv - u[7];
        *(float4*)(PD + (size_t)t * 256 + c8) = d0; *(float4*)(PD + (size_t)t * 256 + c8 + 4) = d1;
    }
}

__device__ void phase_even_states(const Ctx& P, int layer, unsigned char* shm) {
    const int i = layer >> 1, tid = ltid();
    bf16_t* Pb = (bf16_t*)(P.ws + WS_P); bf16_t* YM = (bf16_t*)P.out;
    const bf16_t* XBC = (const bf16_t*)(P.ws + WS_SC + SC_XBC);
    const float* PD = (const float*)(P.ws + WS_SC + SC_PD);
    bf16_t* ST = (bf16_t*)(P.ws + WS_SC + SC_ST); float* CDEC = (float*)(P.ws + WS_MISC + MS_CDEC);
    {
        float* T = (float*)shm;
        const float* pw = P.in[9] + (size_t)i * 4 * 64 * 64; const float* psc = P.in[10] + i * 256;
        const int col = tid & 255, half = tid >> 8, g = col >> 6, j = col & 63;
        float wreg[64];
#pragma unroll
        for (int c = 0; c < 64; ++c) wreg[c] = pw[(g * 64 + c) * 64 + j];
        const float sc = psc[col];
        for (int unit = lbid(); unit < 512; unit += lnb()) {
            const int t0 = unit * 64;
#pragma unroll
            for (int q = 0; q < 8; ++q) { const int i4 = q * 512 + tid; ((float4*)T)[i4] = ((const float4*)(PD + (size_t)t0 * 256))[i4]; }
            __syncthreads();
            for (int tt = 0; tt < 32; ++tt) { const int tok = half * 32 + tt; const float4* row = (const float4*)(T + tok * 256 + g * 64); float acc = 0.f;
#pragma unroll
                for (int c4 = 0; c4 < 16; ++c4) { const float4 d = row[c4]; acc += d.x * wreg[4 * c4] + d.y * wreg[4 * c4 + 1] + d.z * wreg[4 * c4 + 2] + d.w * wreg[4 * c4 + 3]; }
                YM[(size_t)(t0 + tok) * DM + col] = f2bf(acc * sc); }
            __syncthreads();
        }
    }
    {
        bf16_t* Bm = (bf16_t*)shm;
        bf16_t* Cm = Bm + 128 * 136;
        bf16_t* BmT = Cm + 128 * 136;
        bf16_t* XST = BmT + 128 * 136;
        float* cum = (float*)(XST + 64 * 136); float* dts = cum + 768;
        const float* alog = P.in[14] + i * 12;
        const int wave = __builtin_amdgcn_readfirstlane(tid >> 6), lane = tid & 63, hf = lane >> 5, l31 = lane & 31;
        for (int unit = lbid(); unit < 512; unit += lnb()) {
            const int b = unit >> 8, c = (unit >> 1) & 127, g = unit & 1, t0 = b * SEQ + c * 128;
            __syncthreads();
#pragma unroll
            for (int idx = tid; idx < 128 * 16; idx += 512) { const int l = idx >> 4, n8 = (idx & 15) * 8;
                const uint4 rb = *(const uint4*)(XBC + (size_t)(t0 + l) * 1280 + 768 + g * 128 + n8);
                BmT[(n8 + 0) * 136 + l] = (bf16_t)(rb.x & 0xffffu); BmT[(n8 + 1) * 136 + l] = (bf16_t)(rb.x >> 16); BmT[(n8 + 2) * 136 + l] = (bf16_t)(rb.y & 0xffffu); BmT[(n8 + 3) * 136 + l] = (bf16_t)(rb.y >> 16);
                BmT[(n8 + 4) * 136 + l] = (bf16_t)(rb.z & 0xffffu); BmT[(n8 + 5) * 136 + l] = (bf16_t)(rb.z >> 16); BmT[(n8 + 6) * 136 + l] = (bf16_t)(rb.w & 0xffffu); BmT[(n8 + 7) * 136 + l] = (bf16_t)(rb.w >> 16); }
            for (int idx = tid; idx < 768; idx += 512) dts[idx] = tokaux(Pb, t0 + (idx & 127))[g * 6 + (idx >> 7)];
            __syncthreads();
            if (tid < 6) { const float a = -__expf(alog[g * 6 + tid]); float cs = 0.f;
#pragma unroll 8
                for (int l = 0; l < 128; ++l) { cs += dts[tid * 128 + l] * a; cum[tid * 128 + l] = cs; } }
            __syncthreads();
            for (int idx = tid; idx < 768; idx += 512) tokaux(Pb, t0 + (idx & 127))[12 + g * 6 + (idx >> 7)] = cum[idx];
            for (int e = 0; e < 6; ++e) { const int hh = g * 6 + e; const float cl = cum[e * 128 + 127];
                __syncthreads();
#pragma unroll
                for (int q = 0; q < 2; ++q) { const int item = tid + 512 * q, l = item >> 3, p8 = (item & 7) * 8;
                    const uint4 rx = *(const uint4*)(XBC + (size_t)(t0 + l) * 1280 + hh * 64 + p8); float x[8]; unpack8(rx, x);
                    const float sc = dts[e * 128 + l] * __expf(cl - cum[e * 128 + l]);
#pragma unroll
                    for (int j = 0; j < 8; ++j) XST[(p8 + j) * 136 + l] = f2bf(x[j] * sc); }
                __syncthreads();
                { const int pi = wave >> 2, ni = wave & 3; f32x16_t acc;
#pragma unroll
                  for (int q = 0; q < 16; ++q) acc[q] = 0.f;
#pragma unroll
                  for (int ks = 0; ks < 8; ++ks) { const int k = ks * 16 + 8 * hf;
                      const bf16x8_t fa = *(const bf16x8_t*)(XST + (pi * 32 + l31) * 136 + k), fb = *(const bf16x8_t*)(BmT + (ni * 32 + l31) * 136 + k); acc = __builtin_amdgcn_mfma_f32_32x32x16_bf16(fa, fb, acc, 0, 0, 0); }
                  bf16_t* so = ST + ((size_t)(b * 128 + c) * 12 + hh) * 8192 + (pi * 32 + 4 * hf) * 128 + ni * 32 + l31;
#pragma unroll
                  for (int q = 0; q < 16; ++q) so[((q & 3) + 8 * (q >> 2)) * 128] = f2bf(acc[q]); }
                if (tid == 0) CDEC[(b * 128 + c) * 12 + hh] = __expf(cl);
            }
        }
    }
}

__device__ void phase_even_pass(const Ctx& P) {
    bf16_t* ST = (bf16_t*)(P.ws + WS_SC + SC_ST); const float* CDEC = (const float*)(P.ws + WS_MISC + MS_CDEC);
    for (int gt = lbid() * 512 + ltid(); gt < 98304; gt += lnb() * 512) {
        const int b = gt / 49152, rem = gt % 49152, hh = rem >> 12, i2 = rem & 4095;
        float hx = 0.f, hy = 0.f;
        unsigned st[16], st2[16]; float dec[16], dec2[16];
#pragma unroll
        for (int q = 0; q < 16; ++q) { const size_t o = ((size_t)(b * 128 + q) * 12 + hh) * 8192 + i2 * 2; st[q] = *(const unsigned*)(ST + o); dec[q] = CDEC[(b * 128 + q) * 12 + hh]; }
        for (int c0 = 0; c0 < 128; c0 += 16) {
            const int cn = c0 + 16 < 128 ? c0 + 16 : c0;
#pragma unroll
            for (int q = 0; q < 16; ++q) { const size_t o = ((size_t)(b * 128 + cn + q) * 12 + hh) * 8192 + i2 * 2; st2[q] = *(const unsigned*)(ST + o); dec2[q] = CDEC[(b * 128 + cn + q) * 12 + hh]; }
#pragma unroll
            for (int q = 0; q < 16; ++q) { const size_t o = ((size_t)(b * 128 + c0 + q) * 12 + hh) * 8192 + i2 * 2; *(unsigned*)(ST + o) = pack2(hx, hy); hx = hx * dec[q] + bflo(st[q]); hy = hy * dec[q] + bfhi(st[q]); }
#pragma unroll
            for (int q = 0; q < 16; ++q) { st[q] = st2[q]; dec[q] = dec2[q]; }
        }
    }
}

__device__ void phase_even_out(const Ctx& P, int layer, unsigned char* shm) {
    const int i = layer >> 1, tid = ltid(), wave = __builtin_amdgcn_readfirstlane(tid >> 6), lane = tid & 63, hf = lane >> 5, l31 = lane & 31;
    bf16_t* Pb = (bf16_t*)(P.ws + WS_P); bf16_t* YM = (bf16_t*)P.out;
    const bf16_t* XBC = (const bf16_t*)(P.ws + WS_SC + SC_XBC);
    const bf16_t* ST = (const bf16_t*)(P.ws + WS_SC + SC_ST);
    const float* dsk = P.in[15] + i * 12; const float* ng = P.in[16] + i * 768;
    bf16_t* Cm = (bf16_t*)shm;
    bf16_t* Mb = Cm + 128 * 136;
    bf16_t* XT = Mb + 128 * 136;
    bf16_t* PV = XT + 64 * 136;
    float* cumL = (float*)(PV + 64 * 136); float* dtL = cumL + 128; float* SSQ = dtL + 128;
    bf16_t* CBb = (bf16_t*)(SSQ + 256);
    const int li = wave >> 1, pi = wave & 1, p = pi * 32 + l31;
    for (int unit = lbid(); unit < 512; unit += lnb()) {
        const int b = unit >> 8, c = (unit >> 1) & 127, g = unit & 1, t0 = b * SEQ + c * 128;
        __syncthreads();
#pragma unroll
        for (int idx = tid; idx < 128 * 16; idx += 512) { const int l = idx >> 4, n8 = (idx & 15) * 8; *(uint4*)(Cm + l * 136 + n8) = *(const uint4*)(XBC + (size_t)(t0 + l) * 1280 + 1024 + g * 128 + n8);
            *(uint4*)(Mb + l * 136 + n8) = *(const uint4*)(XBC + (size_t)(t0 + l) * 1280 + 768 + g * 128 + n8); }
        __syncthreads();
        {
#pragma unroll
            for (int sj = 0; sj < 2; ++sj) { const int si = (wave & 1) * 2 + sj; f32x16_t acc;
#pragma unroll
                for (int q = 0; q < 16; ++q) acc[q] = 0.f;
#pragma unroll
                for (int ks = 0; ks < 8; ++ks) { const int k = ks * 16 + 8 * hf;
                    const bf16x8_t fa = *(const bf16x8_t*)(Cm + (li * 32 + l31) * 136 + k), fb = *(const bf16x8_t*)(Mb + (si * 32 + l31) * 136 + k); acc = __builtin_amdgcn_mfma_f32_32x32x16_bf16(fa, fb, acc, 0, 0, 0); }
#pragma unroll
                for (int q = 0; q < 16; ++q) CBb[(li * 32 + 4 * hf + (q & 3) + 8 * (q >> 2)) * 136 + si * 32 + l31] = f2bf(acc[q]); } }

        float ssq[16];
#pragma unroll
        for (int reg = 0; reg < 16; ++reg) ssq[reg] = 0.f;
#pragma unroll 1
        for (int e = 0; e < 6; ++e) {
            const int hh = g * 6 + e;
            __syncthreads();
            if (tid < 128) { const float* ax = tokaux(Pb, t0 + tid); cumL[tid] = ax[12 + hh]; dtL[tid] = ax[hh]; }
            __syncthreads();
#pragma unroll 2
            for (int q = 0; q < 4; ++q) { const int item = tid + 512 * q, l = item >> 4, s8 = (item & 15) * 8;
                float v[8]; unpack8(*(const uint4*)(CBb + l * 136 + s8), v); const float cl_ = cumL[l];
#pragma unroll
                for (int j = 0; j < 8; ++j) { const int s = s8 + j; v[j] = (s <= l) ? v[j] * __expf(fminf(cl_ - cumL[s], 0.f)) * dtL[s] : 0.f; }
                *(uint4*)(Mb + l * 136 + s8) = pack8(v); }
#pragma unroll
            for (int q = 0; q < 2; ++q) { const int item = tid + 512 * q, s = item >> 3, p8 = (item & 7) * 8;
                const uint4 rx = *(const uint4*)(XBC + (size_t)(t0 + s) * 1280 + hh * 64 + p8);
                XT[(p8 + 0) * 136 + s] = (bf16_t)(rx.x & 0xffffu); XT[(p8 + 1) * 136 + s] = (bf16_t)(rx.x >> 16); XT[(p8 + 2) * 136 + s] = (bf16_t)(rx.y & 0xffffu); XT[(p8 + 3) * 136 + s] = (bf16_t)(rx.y >> 16);
                XT[(p8 + 4) * 136 + s] = (bf16_t)(rx.z & 0xffffu); XT[(p8 + 5) * 136 + s] = (bf16_t)(rx.z >> 16); XT[(p8 + 6) * 136 + s] = (bf16_t)(rx.w & 0xffffu); XT[(p8 + 7) * 136 + s] = (bf16_t)(rx.w >> 16); }
#pragma unroll
            for (int q = 0; q < 2; ++q) { const int item = tid + 512 * q, pp = item >> 4, n8 = (item & 15) * 8;
                *(uint4*)(PV + pp * 136 + n8) = *(const uint4*)(ST + ((size_t)(b * 128 + c) * 12 + hh) * 8192 + pp * 128 + n8); }
            __syncthreads();
            bf16_t zr[16];
#pragma unroll
            for (int reg = 0; reg < 16; ++reg) zr[reg] = Pb[(size_t)(t0 + li * 32 + 4 * hf + (reg & 3) + 8 * (reg >> 2)) * PP + 256 + hh * 64 + p];
            f32x16_t ad, ao;
#pragma unroll
            for (int q = 0; q < 16; ++q) { ad[q] = 0.f; ao[q] = 0.f; }
            const int nks = (li + 1) * 2;
#pragma unroll
            for (int ks = 0; ks < 8; ++ks) { const int k = ks * 16 + 8 * hf;
                if (ks < nks) { const bf16x8_t fa = *(const bf16x8_t*)(Mb + (li * 32 + l31) * 136 + k), fb = *(const bf16x8_t*)(XT + (pi * 32 + l31) * 136 + k); ad = __builtin_amdgcn_mfma_f32_32x32x16_bf16(fa, fb, ad, 0, 0, 0); }
                const bf16x8_t ga = *(const bf16x8_t*)(Cm + (li * 32 + l31) * 136 + k), gb = *(const bf16x8_t*)(PV + (pi * 32 + l31) * 136 + k); ao = __builtin_amdgcn_mfma_f32_32x32x16_bf16(ga, gb, ao, 0, 0, 0); }
            const float dk = dsk[hh];
#pragma unroll
            for (int reg = 0; reg < 16; ++reg) { const int rl_ = li * 32 + 4 * hf; const int row = rl_ + (reg & 3) + 8 * (reg >> 2);
                const float el = __expf(cumL[row]), xlp = bf2f(XT[p * 136 + row]);
                float y = ad[reg] + el * ao[reg] + dk * xlp;
                y *= siluf_(bf2f(zr[reg]));
                ssq[reg] += y * y;
                YM[(size_t)(t0 + row) * DM + 256 + g * 384 + e * 64 + p] = f2bf(y); }
        }
#pragma unroll
        for (int reg = 0; reg < 16; ++reg) { const int row = li * 32 + 4 * hf + (reg & 3) + 8 * (reg >> 2); const float s = half32_sum(ssq[reg]); if (l31 == 0) SSQ[row * 2 + pi] = s; }
        __syncthreads();
#pragma unroll
        for (int reg = 0; reg < 16; ++reg) { const int row = li * 32 + 4 * hf + (reg & 3) + 8 * (reg >> 2); ssq[reg] = rsqrtf((SSQ[row * 2] + SSQ[row * 2 + 1]) * (1.0f / 384.0f) + 1e-6f); }
#pragma unroll 1
        for (int e = 0; e < 6; ++e) { const float gn = ng[g * 384 + e * 64 + p]; bf16_t* yb = YM + (size_t)(t0 + li * 32 + 4 * hf) * DM + 256 + g * 384 + e * 64 + p; bf16_t yv[16];
#pragma unroll
            for (int reg = 0; reg < 16; ++reg) yv[reg] = yb[(size_t)((reg & 3) + 8 * (reg >> 2)) * DM];
#pragma unroll
            for (int reg = 0; reg < 16; ++reg) yb[(size_t)((reg & 3) + 8 * (reg >> 2)) * DM] = f2bf(bf2f(yv[reg]) * ssq[reg] * gn); }
    }
}

__device__ void phase_odd_prep(const Ctx& P, int layer, unsigned char* shm, bool dry = false) {
    const int i = layer >> 1, tid = ltid(), wave = __builtin_amdgcn_readfirstlane(tid >> 6), lane = tid & 63;
    const int bid = lbid(), nblk = lnb(), h = bid & 7;
    bf16_t* Pb = (bf16_t*)(P.ws + WS_P); bf16_t* YM = (bf16_t*)P.out;
    float* SCW = (float*)(P.ws + WS_SC + SC_W); bf16_t* SCKK = (bf16_t*)(P.ws + WS_SC + SC_KK); bf16_t* SCB = (bf16_t*)(P.ws + WS_SC + SC_B);
    const bf16_t* BND = (const bf16_t*)(P.ws + WS_MISC + MS_BND); float2* AGG = (float2*)(P.ws + WS_MISC + MS_AGG); float* BS = (float*)(P.ws + WS_MISC + MS_BS);
    bf16_t* WU = (bf16_t*)shm;
    bf16_t* AU = WU + 64 * 72;
    bf16_t* GU = AU + 64 * 72;
    bf16_t* WA = GU + 64 * 136;
    bf16_t* WX = WA + 64 * 72;
    bf16_t* AT = WX + 64 * 72;
    bf16_t* AA = AT + 128 * 72;
    bf16_t* AG = AA + 128 * 72;
    bf16_t* AX = AG + 128 * 136;
    float* RED = (float*)(AX + 128 * 72);
    float* AGL = RED + 512;
    bf16_t* RKV = AT;
    const float* mu = P.in[19] + i * 1792;
    const float* w_up = P.in[21] + (size_t)i * 64 * 512; const float* a_up = P.in[23] + (size_t)i * 64 * 512; const float* g_up = P.in[24] + (size_t)i * 128 * 512;
    const float* lcw = P.in[30] + i * 4 * 512; const float* lcb = P.in[31] + i * 512;
    const float* wa = P.in[32] + (size_t)i * 8 * 64 * 64; const float* wx = P.in[34] + (size_t)i * 8 * 64 * 64;
#pragma unroll
    for (int q = 0; q < 8; ++q) { const int e = tid + 512 * q, k = e >> 6, n = e & 63;
        WU[n * 72 + k] = f2bf(w_up[k * 512 + h * 64 + n]); AU[n * 72 + k] = f2bf(a_up[k * 512 + h * 64 + n]);
        WA[n * 72 + k] = f2bf(wa[(h * 64 + k) * 64 + n]); WX[n * 72 + k] = f2bf(wx[(h * 64 + k) * 64 + n]); }
#pragma unroll
    for (int q = 0; q < 16; ++q) { const int e = tid + 512 * q, k = e >> 6, n = e & 63; GU[n * 136 + k] = f2bf(g_up[k * 512 + h * 64 + n]); }
    const int tb = wave >> 1, nb = wave & 1, n = nb * 32 + (lane & 31), hf = lane >> 5, c = h * 64 + n;
    const float mu_r = mu[c], mu_k = mu[512 + c], mu_v = mu[1024 + c];
    const float w0 = P.in[20][i * 512 + c], a0 = P.in[22][i * 512 + c], k_k = P.in[25][i * 512 + c], k_a = P.in[26][i * 512 + c], r_k = P.in[27][i * 512 + c];
    const float ba = P.in[33][i * 512 + c], bx = P.in[35][i * 512 + c], sp = softplusf_(-P.in[36][i * 512 + c]);
    for (int tile = bid >> 3; tile < 256; tile += nblk >> 3) {
        const int t0 = tile * 128; const bool first = (t0 & (SEQ - 1)) == 0;
        __syncthreads();
#pragma unroll 4
        for (int q = 0; q < 8; ++q) { const int item = tid + 512 * q, t = item >> 5, cg = item & 31; const size_t tg = (size_t)t0 + t;
            const uint4 raw = *(const uint4*)(Pb + tg * PP + 1536 + cg * 8);
            uint4 prv; prv.x = 0u; prv.y = 0u; prv.z = 0u; prv.w = 0u; if ((tg & (SEQ - 1)) != 0) prv = *(const uint4*)(Pb + (tg - 1) * PP + 1536 + cg * 8);
            float a[8], p[8]; unpack8(raw, a); unpack8(prv, p);
            const float4 m0 = *(const float4*)(mu + 1536 + cg * 8), m1 = *(const float4*)(mu + 1536 + cg * 8 + 4); const float mm[8] = {m0.x, m0.y, m0.z, m0.w, m1.x, m1.y, m1.z, m1.w};
#pragma unroll
            for (int e = 0; e < 8; ++e) { const float s = a[e] + mm[e] * (p[e] - a[e]); a[e] = cg < 8 ? tanhf_(s) : (cg < 16 ? s : sigmoidf_(s)); }
            bf16_t* dst = cg < 8 ? AT + t * 72 + cg * 8 : (cg < 16 ? AA + t * 72 + (cg - 8) * 8 : AG + t * 136 + (cg - 16) * 8);
            *(uint4*)dst = pack8(a); }
#pragma unroll
        for (int q = 0; q < 2; ++q) { const int item = tid + 512 * q, t = item >> 3, cg = item & 7, cc = h * 64 + cg * 8;
            float acc[8]; { const float4 b0 = *(const float4*)(lcb + cc), b1 = *(const float4*)(lcb + cc + 4); acc[0] = b0.x; acc[1] = b0.y; acc[2] = b0.z; acc[3] = b0.w; acc[4] = b1.x; acc[5] = b1.y; acc[6] = b1.z; acc[7] = b1.w; }
#pragma unroll
            for (int d = 0; d < 4; ++d) { const int tr = t - d; uint4 raw; raw.x = 0u; raw.y = 0u; raw.z = 0u; raw.w = 0u;
                if (tr >= 0) raw = *(const uint4*)(Pb + ((size_t)t0 + tr) * PP + 2304 + cc);
                else if (!first) raw = *(const uint4*)(BND + ((size_t)(tile - 1) * 3 + 3 + tr) * PP + 2304 + cc);
                float x[8]; unpack8(raw, x); const float4 w0v = *(const float4*)(lcw + (3 - d) * 512 + cc), w1v = *(const float4*)(lcw + (3 - d) * 512 + cc + 4);
                acc[0] += w0v.x * x[0]; acc[1] += w0v.y * x[1]; acc[2] += w0v.z * x[2]; acc[3] += w0v.w * x[3]; acc[4] += w1v.x * x[4]; acc[5] += w1v.y * x[5]; acc[6] += w1v.z * x[6]; acc[7] += w1v.w * x[7]; }
            *(uint4*)(AX + t * 72 + cg * 8) = pack8(acc); }
        __syncthreads();
        f32x16_t cw_, ca_, cg_, cr_, ci_;
#pragma unroll
        for (int e = 0; e < 16; ++e) { cw_[e] = 0.f; ca_[e] = 0.f; cg_[e] = 0.f; cr_[e] = 0.f; ci_[e] = 0.f; }
        { const int ar = tb * 32 + (lane & 31), bn = nb * 32 + (lane & 31), ko = 8 * hf;
#pragma unroll
          for (int ks = 0; ks < 4; ++ks) { const int k = ks * 16 + ko;
              const bf16x8_t fa = *(const bf16x8_t*)(AT + ar * 72 + k), fb = *(const bf16x8_t*)(WU + bn * 72 + k); cw_ = __builtin_amdgcn_mfma_f32_32x32x16_bf16(fa, fb, cw_, 0, 0, 0);
              const bf16x8_t ga = *(const bf16x8_t*)(AA + ar * 72 + k), gb = *(const bf16x8_t*)(AU + bn * 72 + k); ca_ = __builtin_amdgcn_mfma_f32_32x32x16_bf16(ga, gb, ca_, 0, 0, 0);
              const bf16x8_t xa = *(const bf16x8_t*)(AX + ar * 72 + k), xb1 = *(const bf16x8_t*)(WA + bn * 72 + k), xb2 = *(const bf16x8_t*)(WX + bn * 72 + k);
              cr_ = __builtin_amdgcn_mfma_f32_32x32x16_bf16(xa, xb1, cr_, 0, 0, 0); ci_ = __builtin_amdgcn_mfma_f32_32x32x16_bf16(xa, xb2, ci_, 0, 0, 0); }
#pragma unroll
          for (int ks = 0; ks < 8; ++ks) { const int k = ks * 16 + ko; const bf16x8_t fa = *(const bf16x8_t*)(AG + ar * 136 + k), fb = *(const bf16x8_t*)(GU + bn * 136 + k); cg_ = __builtin_amdgcn_mfma_f32_32x32x16_bf16(fa, fb, cg_, 0, 0, 0); } }
        __syncthreads();
#pragma unroll
        for (int q = 0; q < 7; ++q) { const int item = tid + 512 * q; if (item < 129 * 32) { const int rr = item >> 5, part = item & 31, arr = part >> 3, cg = part & 7;
            const int col = (arr < 3 ? arr * 512 : 1792) + h * 64 + cg * 8;
            uint4 raw; raw.x = 0u; raw.y = 0u; raw.z = 0u; raw.w = 0u;
            if (rr > 0) raw = *(const uint4*)(Pb + ((size_t)t0 + rr - 1) * PP + col);
            else if (!first) raw = *(const uint4*)(BND + ((size_t)(tile - 1) * 3 + 2) * PP + col);
            *(uint4*)(RKV + rr * 264 + arr * 64 + cg * 8) = raw; } }
        for (int item = tid + 512 * 7; item < 129 * 32; item += 512) { const int rr = item >> 5, part = item & 31, arr = part >> 3, cg = part & 7;
            const int col = (arr < 3 ? arr * 512 : 1792) + h * 64 + cg * 8;
            *(uint4*)(RKV + rr * 264 + arr * 64 + cg * 8) = *(const uint4*)(Pb + ((size_t)t0 + rr - 1) * PP + col); }
        __syncthreads();
#pragma unroll
        for (int reg = 0; reg < 16; ++reg) { int rl_ = tb * 32 + 4 * hf; asm volatile("" : "+v"(rl_)); const int row = rl_ + (reg & 3) + 8 * (reg >> 2);
            const float rr_ = bf2f(RKV[(row + 1) * 264 + n]), rk_ = bf2f(RKV[(row + 1) * 264 + 64 + n]), pr_ = bf2f(RKV[row * 264 + n]), pk_ = bf2f(RKV[row * 264 + 64 + n]);
            const float rs = rr_ + mu_r * (pr_ - rr_), ks = rk_ + mu_k * (pk_ - rk_);
            const float a = sigmoidf_(a0 + ca_[reg]); const float kk = ks * k_k, k2 = ks * (1.0f + (a - 1.0f) * k_a);
            const float ss = half32_sum(kk * kk), bsum = half32_sum(rs * k2 * r_k);
            if ((lane & 31) == 0) { RED[(row * 2 + nb) * 2] = ss; RED[(row * 2 + nb) * 2 + 1] = bsum; }
            }
        __syncthreads();
        float segL[4], segH[4];
#pragma unroll
        for (int reg = 0; reg < 16; ++reg) { int rl_ = tb * 32 + 4 * hf; asm volatile("" : "+v"(rl_)); const int row = rl_ + (reg & 3) + 8 * (reg >> 2); const size_t t = (size_t)t0 + row; bf16_t* prow = Pb + t * PP;
            const float rr_ = bf2f(RKV[(row + 1) * 264 + n]), rk_ = bf2f(RKV[(row + 1) * 264 + 64 + n]), rv_ = bf2f(RKV[(row + 1) * 264 + 128 + n]);
            const float pr_ = bf2f(RKV[row * 264 + n]), pk_ = bf2f(RKV[row * 264 + 64 + n]), pv_ = bf2f(RKV[row * 264 + 128 + n]);
            const float rs = rr_ + mu_r * (pr_ - rr_), ks = rk_ + mu_k * (pk_ - rk_), vs = rv_ + mu_v * (pv_ - rv_);
            const float wl = -softplusf_(-(w0 + cw_[reg])) - 0.5f; const float wdec = __expf(-__expf(wl));
            const float a = sigmoidf_(a0 + ca_[reg]); const float kk = ks * k_k, k2 = ks * (1.0f + (a - 1.0f) * k_a);
            const float ss = RED[(row * 2) * 2] + RED[(row * 2 + 1) * 2]; const float kkn = kk * rsqrtf(ss + 1e-12f), bq = kkn * a;
            if (nb == 0 && (lane & 31) == 0) BS[t * 8 + h] = RED[(row * 2) * 2 + 1] + RED[(row * 2 + 1) * 2 + 1];
            const float gtv = bf2f(RKV[(row + 1) * 264 + 192 + n]);
            bf16_t* pst = dry ? (bf16_t*)(P.ws + WS_SC + 192 * MiB) + (t & 8191) * PP : prow;
            pst[c] = f2bf(rs); pst[512 + c] = f2bf(k2); pst[1024 + c] = f2bf(vs);
            SCW[t * 512 + c] = wdec; SCKK[t * 512 + c] = f2bf(kkn); SCB[t * 512 + c] = f2bf(bq); YM[t * DM + c] = f2bf(cg_[reg]);
            const float rg = sigmoidf_(cr_[reg] + ba), ig = sigmoidf_(ci_[reg] + bx); const float la = -8.0f * rg * sp; const bf16_t la_b = f2bf(la); const float la_r = bf2f(la_b);
            const float mult = __builtin_sqrtf(fmaxf(1.0f - __expf(2.0f * la), 0.f)); const float bl = mult * ig * bf2f(AX[row * 72 + n]); const bf16_t bl_b = f2bf(bl);
            YM[t * DM + 512 + c] = f2bf(gelu_tanh_(gtv)); pst[1792 + c] = la_b; pst[2304 + c] = bl_b;
            if ((reg & 3) == 0) { segL[reg >> 2] = la_r; segH[reg >> 2] = bf2f(bl_b); } else { segL[reg >> 2] += la_r; segH[reg >> 2] = __expf(la_r) * segH[reg >> 2] + bf2f(bl_b); }
            }
        { float L = 0.f, H = 0.f;
#pragma unroll
          for (int r = 0; r < 4; ++r) { const float oL = __shfl_xor(segL[r], 32), oH = __shfl_xor(segH[r], 32);
              const float L0 = hf ? oL : segL[r], H0 = hf ? oH : segH[r], L1 = hf ? segL[r] : oL, H1 = hf ? segH[r] : oH;
              H = __expf(L0) * H + H0; L += L0; H = __expf(L1) * H + H1; L += L1; }
          if (hf == 0) { AGL[(tb * 64 + n) * 2] = L; AGL[(tb * 64 + n) * 2 + 1] = H; } }
        __syncthreads();
        if (tid < 64) { float L = 0.f, H = 0.f;
#pragma unroll
            for (int r = 0; r < 4; ++r) { const float Ls = AGL[(r * 64 + tid) * 2], Hs = AGL[(r * 64 + tid) * 2 + 1]; H = __expf(Ls) * H + Hs; L += Ls; }
            AGG[tile * 512 + h * 64 + tid] = make_float2(L, H); }
    }
}

#define RING_BAR() do { asm volatile("s_waitcnt lgkmcnt(0)" ::: "memory"); __builtin_amdgcn_s_barrier(); asm volatile("" ::: "memory"); } while (0)
struct ScanStep { float4 w; uint2 kk, bb, kv, rv; float vv; };
__device__ void phase_odd_scan(const Ctx& P, unsigned char* shm) {
    const int tid = ltid(), wave = __builtin_amdgcn_readfirstlane(tid >> 6), lane = tid & 63;
    bf16_t* Pb = (bf16_t*)(P.ws + WS_P); bf16_t* YM = (bf16_t*)P.out;
    const float2* AGG = (const float2*)(P.ws + WS_MISC + MS_AGG);
    for (int task = lbid() * 8 + wave; task < 2048; task += lnb() * 8) {
        const int tile = task >> 3, c = (task & 7) * 64 + lane;
        float h = 0.f;
#pragma unroll 8
        for (int i = tile & ~127; i < tile; ++i) { const float2 ag = AGG[i * 512 + c]; h = __expf(ag.x) * h + ag.y; }
        {
            bf16_t la[16], bl[16], gg[16], la2[16], bl2[16], gg2[16];
#pragma unroll
            for (int q = 0; q < 16; ++q) { const size_t t = (size_t)tile * 128 + q; la[q] = Pb[t * PP + 1792 + c]; bl[q] = Pb[t * PP + 2304 + c]; gg[q] = YM[t * DM + 512 + c]; }
            for (int tb = 0; tb < 128; tb += 16) {
                const int tn = tb + 16 < 128 ? tb + 16 : tb;
#pragma unroll
                for (int q = 0; q < 16; ++q) { const size_t t = (size_t)tile * 128 + tn + q; la2[q] = Pb[t * PP + 1792 + c]; bl2[q] = Pb[t * PP + 2304 + c]; gg2[q] = YM[t * DM + 512 + c]; }
#pragma unroll
                for (int q = 0; q < 16; ++q) { const size_t t = (size_t)tile * 128 + tb + q; h = __expf(bf2f(la[q])) * h + bf2f(bl[q]); YM[t * DM + 512 + c] = f2bf(h * bf2f(gg[q])); }
#pragma unroll
                for (int q = 0; q < 16; ++q) { la[q] = la2[q]; bl[q] = bl2[q]; gg[q] = gg2[q]; }
            }
        }
    }
    __syncthreads();
#ifdef SCAN_TWICE
    for (int rep_ = 0; rep_ < 2; ++rep_)
#endif
    {
        typedef float f32x2 __attribute__((ext_vector_type(2)));
        const float* __restrict__ SCW = (const float*)(P.ws + WS_SC + SC_W); const bf16_t* __restrict__ SCKK = (const bf16_t*)(P.ws + WS_SC + SC_KK); const bf16_t* __restrict__ SCB = (const bf16_t*)(P.ws + WS_SC + SC_B);
        float* SCY = (float*)(P.ws + WS_SC + SC_Y);
        constexpr int CH = 32, NCH = SEQ / CH, BUFF = 16384;
        float* ring = (float*)shm;
        for (int task = lbid(); task < 256; task += lnb()) {
            const int xcd = task & 7, slot = task >> 3, bh = xcd * 2 + (slot >> 4), b = bh >> 3, hd = bh & 7, v0 = (slot & 15) * 4;
            const size_t tokb = (size_t)b * SEQ;
            if (wave != 0) {
                const int role = wave - 1;
                uint4 ra[4], rb[4];
#define RW_ISSUE(r, t0_) do { \
                    if (role < 2) { _Pragma("unroll") for (int i_ = 0; i_ < 4; ++i_) { const int idx_ = role * 256 + i_ * 64 + lane; const size_t tk_ = tokb + (t0_) + (idx_ >> 4); r[i_] = *(const uint4*)(SCW + tk_ * 512 + hd * 64 + 4 * (idx_ & 15)); } } \
                    else if (role < 5) { const bf16_t* sb_ = role == 2 ? SCKK + hd * 64 : (role == 3 ? SCB + hd * 64 : Pb + hd * 64); const size_t pitch_ = role == 4 ? PP : 512; \
                        _Pragma("unroll") for (int i_ = 0; i_ < 4; ++i_) { const int ia_ = (2 * i_) * 64 + lane, ib_ = (2 * i_ + 1) * 64 + lane; \
                            const uint2 a_ = *(const uint2*)(sb_ + (tokb + (t0_) + (ia_ >> 4)) * pitch_ + 4 * (ia_ & 15)), c_ = *(const uint2*)(sb_ + (tokb + (t0_) + (ib_ >> 4)) * pitch_ + 4 * (ib_ & 15)); \
                            r[i_].x = a_.x; r[i_].y = a_.y; r[i_].z = c_.x; r[i_].w = c_.y; } } \
                    else { _Pragma("unroll") for (int i_ = 0; i_ < 4; ++i_) { const int idx_ = (role - 5) * 256 + i_ * 64 + lane; const bf16_t* row_ = Pb + (tokb + (t0_) + (idx_ >> 4)) * PP + hd * 64; \
                            const uint2 a_ = *(const uint2*)(row_ + 512 + 4 * (idx_ & 15)), c_ = *(const uint2*)(row_ + 1024 + v0); r[i_].x = a_.x; r[i_].y = a_.y; r[i_].z = c_.x; r[i_].w = c_.y; } } } while (0)
#define RW_COMMIT(r, buf_) do { float* base_ = ring + (buf_) * BUFF; \
                    if (role < 2) { _Pragma("unroll") for (int i_ = 0; i_ < 4; ++i_) { const int idx_ = role * 256 + i_ * 64 + lane; *(uint4*)(base_ + (idx_ >> 4) * 64 + 4 * (idx_ & 15)) = r[i_]; } } \
                    else if (role < 5) { float* ab_ = base_ + 2048 * (role - 1); \
                        _Pragma("unroll") for (int i_ = 0; i_ < 4; ++i_) { const int ia_ = (2 * i_) * 64 + lane, ib_ = (2 * i_ + 1) * 64 + lane; float4 o_; \
                            o_.x = bflo(r[i_].x); o_.y = bfhi(r[i_].x); o_.z = bflo(r[i_].y); o_.w = bfhi(r[i_].y); *(float4*)(ab_ + (ia_ >> 4) * 64 + 4 * (ia_ & 15)) = o_; \
                            o_.x = bflo(r[i_].z); o_.y = bfhi(r[i_].z); o_.z = bflo(r[i_].w); o_.w = bfhi(r[i_].w); *(float4*)(ab_ + (ib_ >> 4) * 64 + 4 * (ib_ & 15)) = o_; } } \
                    else { _Pragma("unroll") for (int i_ = 0; i_ < 4; ++i_) { const int idx_ = (role - 5) * 256 + i_ * 64 + lane; float* d_ = base_ + 8192 + (idx_ >> 4) * 256 + 4 * (idx_ & 15); \
                            const float k0_ = bflo(r[i_].x), k1_ = bfhi(r[i_].x), k2_ = bflo(r[i_].y), k3_ = bfhi(r[i_].y), va_ = bflo(r[i_].z), vb_ = bfhi(r[i_].z), vc_ = bflo(r[i_].w), vd_ = bfhi(r[i_].w); float4 t_; \
                            t_.x = k0_ * va_; t_.y = k1_ * va_; t_.z = k2_ * va_; t_.w = k3_ * va_; *(float4*)d_ = t_; \
                            t_.x = k0_ * vb_; t_.y = k1_ * vb_; t_.z = k2_ * vb_; t_.w = k3_ * vb_; *(float4*)(d_ + 64) = t_; \
                            t_.x = k0_ * vc_; t_.y = k1_ * vc_; t_.z = k2_ * vc_; t_.w = k3_ * vc_; *(float4*)(d_ + 128) = t_; \
                            t_.x = k0_ * vd_; t_.y = k1_ * vd_; t_.z = k2_ * vd_; t_.w = k3_ * vd_; *(float4*)(d_ + 192) = t_; } } } while (0)
                RW_ISSUE(ra, 0); RW_COMMIT(ra, 0); RW_ISSUE(rb, CH); RW_ISSUE(ra, 2 * CH);
                RING_BAR();
                for (int ci = 0; ci < NCH; ci += 2) {
                    RW_COMMIT(rb, 1); if (ci + 3 < NCH) RW_ISSUE(rb, (ci + 3) * CH);
                    RING_BAR();
                    if (ci + 2 < NCH) { RW_COMMIT(ra, 0); if (ci + 4 < NCH) RW_ISSUE(ra, (ci + 4) * CH); }
                    RING_BAR();
                }
#undef RW_ISSUE
#undef RW_COMMIT
            } else {
                const int q = lane >> 4, j = lane & 15;
                f32x2 s01 = {0.f, 0.f}, s23 = {0.f, 0.f};
                const bool odd1 = (j & 1) != 0, odd2 = (j & 2) != 0; const int jq = j >> 2;
                float* yout = SCY + tokb * 512 + hd * 64 + v0 + (size_t)(4 * (j >> 2) + 2 * (j & 1) + ((j >> 1) & 1)) * 512 + q;
                RING_BAR();
                for (int ci = 0; ci < NCH; ++ci) {
                    const float* B = ring + (ci & 1) * BUFF;
                    float4 Lw[3], Lkk[3], Lbb[3], Lrv[3], Lvk[3];
#define SC_LD(sl_, u_) do { Lw[sl_] = *(const float4*)(B + (u_) * 64 + 4 * j); Lkk[sl_] = *(const float4*)(B + 2048 + (u_) * 64 + 4 * j); Lbb[sl_] = *(const float4*)(B + 4096 + (u_) * 64 + 4 * j); \
                        Lrv[sl_] = *(const float4*)(B + 6144 + (u_) * 64 + 4 * j); Lvk[sl_] = *(const float4*)(B + 8192 + (u_) * 256 + q * 64 + 4 * j); } while (0)
                    SC_LD(0, 0); SC_LD(1, 1);
                    float yacc = 0.f, yp0 = 0.f, yp1 = 0.f, yp2 = 0.f, yp3 = 0.f;
#pragma unroll
                    for (int u = 0; u < 32; ++u) {
                        if (u + 2 < 32) SC_LD((u + 2) % 3, u + 2);
                        if (u > 0 && (u & 3) == 0) {
                            const float sa_ = odd1 ? yp2 : yp0, sb_ = odd1 ? yp3 : yp1, ta_ = odd1 ? yp0 : yp2, tb_ = odd1 ? yp1 : yp3;
                            const float n0 = sa_ + __builtin_bit_cast(float, __builtin_amdgcn_update_dpp(0, __builtin_bit_cast(int, ta_), 0xB1, 0xF, 0xF, true));
                            const float n1 = sb_ + __builtin_bit_cast(float, __builtin_amdgcn_update_dpp(0, __builtin_bit_cast(int, tb_), 0xB1, 0xF, 0xF, true));
                            const float sc_ = odd2 ? n1 : n0, tc_ = odd2 ? n0 : n1;
                            float m_ = sc_ + __builtin_bit_cast(float, __builtin_amdgcn_update_dpp(0, __builtin_bit_cast(int, tc_), 0x4E, 0xF, 0xF, true));
                            m_ += __builtin_bit_cast(float, __builtin_amdgcn_update_dpp(0, __builtin_bit_cast(int, m_), 0x128, 0xF, 0xF, true));
                            m_ += __builtin_bit_cast(float, __builtin_amdgcn_update_dpp(0, __builtin_bit_cast(int, m_), 0x124, 0xF, 0xF, true));
                            yacc = (jq == (((u - 4) >> 2) & 3)) ? m_ : yacc;
                            if ((u & 15) == 0) yout[(size_t)(ci * CH + (u - 16)) * 512] = yacc; }
                        const float4 w = Lw[u % 3], kk = Lkk[u % 3], bb = Lbb[u % 3], rv = Lrv[u % 3], vk = Lvk[u % 3];
                        const f32x2 kk01 = {kk.x, kk.y}, kk23 = {kk.z, kk.w}, bb01 = {bb.x, bb.y}, bb23 = {bb.z, bb.w}, vk01 = {vk.x, vk.y}, vk23 = {vk.z, vk.w}, w01 = {w.x, w.y}, w23 = {w.z, w.w}, r01 = {rv.x, rv.y}, r23 = {rv.z, rv.w};
                        const f32x2 q01 = s01 * w01 + vk01, q23 = s23 * w23 + vk23;
                        f32x2 d2 = s01 * kk01; d2 = s23 * kk23 + d2;
                        float dot = d2.x + d2.y; dot = row16_sum(dot);
                        const f32x2 sa2 = {-dot, -dot};
                        s01 = sa2 * bb01 + q01;
                        s23 = sa2 * bb23 + q23;
                        f32x2 y2 = s01 * r01; y2 = s23 * r23 + y2;
                        const float ypn = y2.x + y2.y;
                        if ((u & 3) == 0) yp0 = ypn; else if ((u & 3) == 1) yp1 = ypn; else if ((u & 3) == 2) yp2 = ypn; else yp3 = ypn;
                    }
                    {
                        const float sa_ = odd1 ? yp2 : yp0, sb_ = odd1 ? yp3 : yp1, ta_ = odd1 ? yp0 : yp2, tb_ = odd1 ? yp1 : yp3;
                        const float n0 = sa_ + __builtin_bit_cast(float, __builtin_amdgcn_update_dpp(0, __builtin_bit_cast(int, ta_), 0xB1, 0xF, 0xF, true));
                        const float n1 = sb_ + __builtin_bit_cast(float, __builtin_amdgcn_update_dpp(0, __builtin_bit_cast(int, tb_), 0xB1, 0xF, 0xF, true));
                        const float sc_ = odd2 ? n1 : n0, tc_ = odd2 ? n0 : n1;
                        float m_ = sc_ + __builtin_bit_cast(float, __builtin_amdgcn_update_dpp(0, __builtin_bit_cast(int, tc_), 0x4E, 0xF, 0xF, true));
                        m_ += __builtin_bit_cast(float, __builtin_amdgcn_update_dpp(0, __builtin_bit_cast(int, m_), 0x128, 0xF, 0xF, true));
                        m_ += __builtin_bit_cast(float, __builtin_amdgcn_update_dpp(0, __builtin_bit_cast(int, m_), 0x124, 0xF, 0xF, true));
                        yacc = (jq == 3) ? m_ : yacc;
                        yout[(size_t)(ci * CH + 16) * 512] = yacc; }
#undef SC_LD
                    RING_BAR();
                }
            }
        }
    }
}

__device__ __forceinline__ float oct_sum(float x) {
    x += __builtin_bit_cast(float, __builtin_amdgcn_update_dpp(0, __builtin_bit_cast(int, x), 0xB1, 0xF, 0xF, true));
    x += __builtin_bit_cast(float, __builtin_amdgcn_update_dpp(0, __builtin_bit_cast(int, x), 0x4E, 0xF, 0xF, true));
    x += __builtin_bit_cast(float, __builtin_amdgcn_update_dpp(0, __builtin_bit_cast(int, x), 0x141, 0xF, 0xF, true));
    return x;
}
__device__ void phase_odd_post(const Ctx& P, int layer) {
    const int i = layer >> 1, tid = ltid(), lane = tid & 63;
    const bf16_t* Pb = (const bf16_t*)(P.ws + WS_P); bf16_t* YM = (bf16_t*)P.out;
    const float* SCY = (const float*)(P.ws + WS_SC + SC_Y); const float* BS = (const float*)(P.ws + WS_MISC + MS_BS);
    const float* lng = P.in[28] + i * 512; const float* lnbias = P.in[29] + i * 512;
    const int c8 = lane * 8, hd = lane >> 3;
    float gw[8], gb[8];
    { const float4 a0 = *(const float4*)(lng + c8), a1 = *(const float4*)(lng + c8 + 4), b0 = *(const float4*)(lnbias + c8), b1 = *(const float4*)(lnbias + c8 + 4);
      gw[0] = a0.x; gw[1] = a0.y; gw[2] = a0.z; gw[3] = a0.w; gw[4] = a1.x; gw[5] = a1.y; gw[6] = a1.z; gw[7] = a1.w; gb[0] = b0.x; gb[1] = b0.y; gb[2] = b0.z; gb[3] = b0.w; gb[4] = b1.x; gb[5] = b1.y; gb[6] = b1.z; gb[7] = b1.w; }
    const int tstep = lnb() * 8; int t = lbid() * 8 + (tid >> 6);
    float4 y0, y1; uint4 vr, gr; float bs;
    if (t < M_TOK) { y0 = *(const float4*)(SCY + (size_t)t * 512 + c8); y1 = *(const float4*)(SCY + (size_t)t * 512 + c8 + 4); vr = *(const uint4*)(Pb + (size_t)t * PP + 1024 + c8); gr = *(const uint4*)(YM + (size_t)t * DM + c8); bs = BS[t * 8 + hd]; }
    for (; t < M_TOK; t += tstep) {
        const int tn = t + tstep < M_TOK ? t + tstep : t;
        const float4 ny0 = *(const float4*)(SCY + (size_t)tn * 512 + c8), ny1 = *(const float4*)(SCY + (size_t)tn * 512 + c8 + 4);
        const uint4 nvr = *(const uint4*)(Pb + (size_t)tn * PP + 1024 + c8), ngr = *(const uint4*)(YM + (size_t)tn * DM + c8); const float nbs = BS[tn * 8 + hd];
        float y[8] = {y0.x, y0.y, y0.z, y0.w, y1.x, y1.y, y1.z, y1.w}, v[8], g[8]; unpack8(vr, v); unpack8(gr, g);
        float s = 0.f;
#pragma unroll
        for (int e = 0; e < 8; ++e) s += y[e];
        const float mean = oct_sum(s) * (1.0f / 64.0f);
        float q = 0.f;
#pragma unroll
        for (int e = 0; e < 8; ++e) { y[e] -= mean; q += y[e] * y[e]; }
        const float rstd = rsqrtf(oct_sum(q) * (1.0f / 64.0f) + 64e-5f);
#pragma unroll
        for (int e = 0; e < 8; ++e) y[e] = (y[e] * rstd * gw[e] + gb[e] + bs * v[e]) * g[e];
        *(uint4*)(YM + (size_t)t * DM + c8) = pack8(y);
        y0 = ny0; y1 = ny1; vr = nvr; gr = ngr; bs = nbs;
    }
}

#define XB_TMO      128
#define XB_XCNT(j)  (256  + 64 * (j))
#define XB_XSUB(j)  (1280 + 64 * (j))
#define XB_XGEN(j)  (2304 + 64 * (j))
#define XB_TOP      3328
#define XB_TOPGEN   3392
#define XCD_BAR_WORDS 3456
#define XB_SPIN_CAP (1u << 18)

__device__ __forceinline__ unsigned xb_ld(unsigned* p)              { return __hip_atomic_load(p, __ATOMIC_RELAXED, __HIP_MEMORY_SCOPE_AGENT); }
__device__ __forceinline__ unsigned xb_add(unsigned* p, unsigned v) { return __hip_atomic_fetch_add(p, v, __ATOMIC_RELAXED, __HIP_MEMORY_SCOPE_AGENT); }
__device__ __forceinline__ unsigned xb_xcc_id() { return (unsigned)__builtin_amdgcn_s_getreg((3 << 11) | 20) & 0xFu; }
#define XB_SPIN(cond, bar) do { unsigned _sp = 0; while (cond) { __builtin_amdgcn_s_sleep(1); \
    if ((++_sp & 255u) == 0u) { if (xb_ld(&(bar)[XB_TMO])) break; if (_sp > XB_SPIN_CAP) { atomicAdd(&(bar)[XB_TMO], 1u); break; } } } } while (0)

struct XcdBarrier {
    unsigned* bar; unsigned x;
    volatile LAS unsigned* st;
};

__device__ __forceinline__ XcdBarrier xcd_barrier_post(unsigned* bar, volatile LAS unsigned* st) {
    XcdBarrier b; b.bar = bar; b.x = xb_xcc_id(); b.st = st;
    if (threadIdx.x == 0) (void)xb_add(&bar[XB_XCNT(b.x)], 1u);
    return b;
}
__device__ __forceinline__ void xcd_barrier_complete(unsigned* bar, unsigned x, unsigned& nloc, unsigned& nx) {
    const unsigned G = gridDim.x * gridDim.y * gridDim.z;
    unsigned sum, cnt, mine, sp = 0u;
    for (;;) {
        sum = 0u; cnt = 0u; mine = 0u;
#pragma unroll
        for (unsigned j = 0; j < 16; ++j) { const unsigned c = xb_ld(&bar[XB_XCNT(j)]); sum += c; cnt += (c > 0u) ? 1u : 0u; mine = (j == x) ? c : mine; }
        if (sum == G) break;
        __builtin_amdgcn_s_sleep(1);
        if ((++sp & 255u) == 0u) { if (xb_ld(&bar[XB_TMO])) break; if (sp > XB_SPIN_CAP) { atomicAdd(&bar[XB_TMO], 1u); break; } }
    }
    nloc = mine > 0u ? mine : 1u; nx = cnt > 0u ? cnt : 1u;
}

__device__ __forceinline__ void xcd_barrier(const XcdBarrier& b) {
    asm volatile("s_waitcnt vmcnt(0)" ::: "memory");
    __syncthreads();
    if (threadIdx.x == 0) {
        unsigned* bar = b.bar;
        __builtin_amdgcn_s_waitcnt(0);
        unsigned nloc = b.st[0], nx = b.st[1];
        if (nloc == 0u) { xcd_barrier_complete(bar, b.x, nloc, nx); b.st[0] = nloc; b.st[1] = nx; }
        const unsigned old = xb_add(&bar[XB_XSUB(b.x)], 1u);
        const unsigned gen = old / nloc;
        if (old + 1u == (gen + 1u) * nloc) {
            __builtin_amdgcn_fence(__ATOMIC_RELEASE, "agent");
            asm volatile("s_waitcnt vmcnt(0)" ::: "memory");
            const unsigned og = xb_add(&bar[XB_TOP], 1u);
            const unsigned tg = og / nx;
            if (og + 1u == (tg + 1u) * nx) xb_add(&bar[XB_TOPGEN], 1u);
            else XB_SPIN(xb_ld(&bar[XB_TOPGEN]) == tg, bar);
            __builtin_amdgcn_fence(__ATOMIC_ACQUIRE, "agent");
            xb_add(&bar[XB_XGEN(b.x)], 1u);
            asm volatile("s_waitcnt vmcnt(0)" ::: "memory");
        } else {
            XB_SPIN(xb_ld(&bar[XB_XGEN(b.x)]) == gen, bar);
            __builtin_amdgcn_fence(__ATOMIC_ACQUIRE, "agent");
            asm volatile("s_waitcnt vmcnt(0)" ::: "memory");
        }
    }
    __syncthreads();
}

#ifndef REPEAT_ODD
#define REPEAT_ODD -1
#endif
#ifndef SUBMASK
#define SUBMASK 0x3ff
#endif
#define EN(s) (((SUBMASK) >> (s)) & 1)
#ifndef PH_ODD_FORCE
#define PH_ODD_FORCE
#endif
constexpr int N_PHASES = 41;
__host__ __device__ inline bool phase_is_noop(int ph) { return ph < 40 && ((ph / 10) & 1) && (ph % 10) == 5; }

__device__ __forceinline__ void run_phase(const Ctx& P, int ph, unsigned char* shm) {
    bf16_t* HN = (bf16_t*)(P.ws + WS_HN); bf16_t* Pb = (bf16_t*)(P.ws + WS_P); bf16_t* HB2 = (bf16_t*)(P.ws + WS_SC + SC_HB2);
    float* SS1 = (float*)(P.ws + WS_SC + SC_SSP1); float* SS2 = (float*)(P.ws + WS_SC + SC_SSP2); float* RS1 = (float*)(P.ws + WS_MISC + MS_SS1); float* RS2 = (float*)(P.ws + WS_MISC + MS_SS2);
    if (ph == 40) { phase_final_norm(HN, P.out, P.in[6], SS1); return; }
    const int layer = ph / 10, sub = ph % 10; const bool odd = (layer & 1) PH_ODD_FORCE;
#ifdef ONLY_SUB
    if (sub != ONLY_SUB) return;
#endif
    switch (sub) {
    case 0: if (EN(0)) { phase_convert(P, layer, shm); if (layer == 0) phase_x_to_bf16(P.in[0], HN, RS1); else finalize_rstd(SS1, RS1);
#ifdef FILL_PROBE
              if (layer == 0) { uint4 z; z.x = 0u; z.y = 0u; z.z = 0u; z.w = 0u; uint4* fp = (uint4*)(P.ws + WS_SC + 128 * MiB); for (size_t i_ = (size_t)lbid() * 512 + ltid(); i_ < 80 * MiB / 16; i_ += (size_t)lnb() * 512) fp[i_] = z; }
#endif
            } break;
    case 1: if (EN(1)) { pg8::Gemm g{HN, (const bf16_t*)(P.ws + WS_WIN), M_TOK, odd ? 2816 : 2560, 1024}; pg8::StaticOrder S; S.init(g.M, g.N, lnb(), lbid());
              EpiP E{Pb, odd ? (bf16_t*)(P.ws + WS_MISC + MS_BND) : nullptr, RS1}; pg8::gemm_phase<EpiP, pg8::StaticOrder>((PG8_LAS unsigned char*)shm, g, S, E, nullptr); } break;
#ifdef DRY_ODD_PREP
    case 2: if (EN(2)) { if (odd) { phase_odd_prep(P, layer, shm, true); __syncthreads(); phase_odd_prep(P, layer, shm); } else phase_even_prep(P, layer); } break;
#else
    case 2: if (EN(2)) { if (odd) phase_odd_prep(P, layer, shm); else phase_even_prep(P, layer); } break;
#endif
    case 3: if (EN(3)) { if (odd) phase_odd_scan(P, shm); else phase_even_states(P, layer, shm); } break;
    case 4: if (EN(4)) { if (odd) phase_odd_post(P, layer); else phase_even_pass(P); } break;
    case 5: if (EN(5)) { if (!odd) phase_even_out(P, layer, shm); } break;
    case 6: if (EN(6)) { pg8::Gemm g{(const bf16_t*)P.out, (const bf16_t*)(P.ws + WS_WOUT), M_TOK, 1024, 1024}; pg8::StaticOrder S; S.init(g.M, g.N, lnb(), lbid());
              EpiRes E{HN, HB2, SS2}; pg8::gemm_phase<EpiRes, pg8::StaticOrder>((PG8_LAS unsigned char*)shm, g, S, E, nullptr); } break;
    case 7: if (EN(7)) finalize_rstd(SS2, RS2); break;
    case 8: if (EN(8)) { pg8::Gemm g{HB2, (const bf16_t*)(P.ws + WS_WGU), M_TOK, 5632, 1024}; pg8::StaticOrder S; S.init(g.M, g.N, lnb(), lbid());
              EpiSwi E{Pb, RS2}; pg8::gemm_phase<EpiSwi, pg8::StaticOrder>((PG8_LAS unsigned char*)shm, g, S, E, nullptr); } break;
    case 9: if (EN(9)) {
#ifdef STAGGER_US
              if (lbid() & 4) { const unsigned long long t0_ = __builtin_amdgcn_s_memrealtime(); while (__builtin_amdgcn_s_memrealtime() - t0_ < (unsigned long long)(STAGGER_US) * 100ull) __builtin_amdgcn_s_sleep(8); }
#endif
              pg8::Gemm g{Pb, (const bf16_t*)(P.ws + WS_WDN), M_TOK, 1024, 2816}; pg8::StaticOrder S; S.init(g.M, g.N, lnb(), lbid());
              EpiRes E{HB2, HN, SS1}; pg8::gemm_phase<EpiRes, pg8::StaticOrder>((PG8_LAS unsigned char*)shm, g, S, E, nullptr); } break;
    }
}

__global__ void __launch_bounds__(512, 2) k_main(Params P) {
    extern __shared__ __attribute__((aligned(16))) unsigned char shm[];
    cg::grid_group grid = cg::this_grid();
    volatile LAS unsigned* bst = (volatile LAS unsigned*)((LAS unsigned char*)shm + LDS_BYTES - 16);
    if (threadIdx.x < 2) bst[threadIdx.x] = 0u;
    __syncthreads();
    (void)xcd_barrier_post((unsigned*)(P.ws + WS_MISC + MS_BAR), bst);
    int nsync = 0;
#define GRID_BAR() do { int zb_ = 0; asm volatile("" : "+s"(zb_)); XcdBarrier bar_; bar_.bar = (unsigned*)(P.ws + zb_ + WS_MISC + MS_BAR); bar_.x = xb_xcc_id(); \
        bar_.st = (volatile LAS unsigned*)((LAS unsigned char*)shm + LDS_BYTES - 16); xcd_barrier(bar_); } while (0)
    bool first = true;
#ifdef EXTRA_SYNCS
    for (int es_ = 0; es_ < EXTRA_SYNCS; ++es_) GRID_BAR();
#endif
    for (int ph = P.ph_lo; ph < P.ph_hi; ++ph) {
        if (phase_is_noop(ph)) continue;
        if (!first) { if (nsync == 0) grid.sync(); else GRID_BAR(); nsync = 1; }
        first = false;
        int z = 0; asm volatile("" : "+s"(z));
        Ctx C; C.in.p = &P; C.in.z = z; C.out = P.out + z; C.ws = P.ws + z;
        run_phase(C, ph, shm);
#ifdef REPEAT_MASK
        if (ph < 40 && ((REPEAT_MASK >> (ph % 10)) & 1) && (REPEAT_ODD < 0 || ((ph / 10) & 1) == REPEAT_ODD)) { GRID_BAR(); run_phase(C, ph, shm); }
#endif

    }
}

#ifndef MK_ONE_LAUNCH
#define MK_ONE_LAUNCH 1
#endif
extern "C" void kernel_launch(void* const* d_in, const int* in_sizes, int n_in, void* d_out, int out_size, void* d_ws, size_t ws_size, hipStream_t stream) {
    static int state = 0;
    if (state == 0) {
        if (n_in != NIN || out_size != M_TOK * DM || ws_size < WS_END) { fprintf(stderr, "kernel_launch: unexpected shapes (n_in %d out %d ws %zu)\n", n_in, out_size, ws_size); state = -1; return; }
        if (hipFuncSetAttribute((const void*)k_main, hipFuncAttributeMaxDynamicSharedMemorySize, LDS_BYTES) != hipSuccess) { fprintf(stderr, "kernel_launch: hipFuncSetAttribute failed\n"); state = -1; return; }
        int dev = 0, cus = 0, per_cu = 0;
        if (hipGetDevice(&dev) != hipSuccess || hipDeviceGetAttribute(&cus, hipDeviceAttributeMultiprocessorCount, dev) != hipSuccess || cus < 8) { fprintf(stderr, "kernel_launch: cannot query the CU count\n"); state = -1; return; }
        if (hipOccupancyMaxActiveBlocksPerMultiprocessor(&per_cu, (const void*)k_main, 512, LDS_BYTES) != hipSuccess || per_cu < 1) fprintf(stderr, "kernel_launch: note: occupancy query reports %d workgroups per CU\n", per_cu);
        (void)hipGetLastError();
        state = (cus < 256 ? cus : 256) & ~7;
    }
    if (state < 0) return;
    if (hipMemsetAsync((unsigned char*)d_ws + WS_MISC + MS_BAR, 0, BAR_BYTES, stream) != hipSuccess) { fprintf(stderr, "kernel_launch: memset failed\n"); return; }
    Params p{};
    for (int i = 0; i < NIN; ++i) p.in[i] = (const float*)d_in[i];
    p.out = (float*)d_out; p.ws = (unsigned char*)d_ws;
#if MK_ONE_LAUNCH
    p.ph_lo = 0; p.ph_hi = N_PHASES;
    void* args[] = {&p};
    hipError_t e = hipLaunchCooperativeKernel((const void*)k_main, dim3(state), dim3(512), args, LDS_BYTES, stream);
    if (e != hipSuccess) fprintf(stderr, "cooperative launch failed: %s\n", hipGetErrorString(e));
#else
    for (int ph = 0; ph < N_PHASES; ++ph) { if (phase_is_noop(ph)) continue; p.ph_lo = ph; p.ph_hi = ph + 1; hipLaunchKernelGGL(k_main, dim3(state), dim3(512), LDS_BYTES, stream, p); }
#endif
}
```

```cpp
#include <hip/hip_runtime.h>
#include <hip/hip_cooperative_groups.h>
#include <cstdio>
namespace cg = cooperative_groups;

typedef unsigned short bf16_t;
constexpr int M_TOK = 32768, SEQ = 16384, DM = 1024, FF = 2816, PP = 2816;
constexpr int LDS_BYTES = 163840;
constexpr int NIN = 37;

constexpr size_t MiB = 1048576;
constexpr size_t WS_WIN = 0, WS_WOUT = 5767168, WS_WGU = 7864320, WS_WDN = 19398656;
constexpr size_t WS_HN = 24 * MiB, WS_P = 88 * MiB, WS_SC = 264 * MiB, WS_MISC = 504 * MiB, WS_END = 512 * MiB;
constexpr size_t SC_XBC = 0, SC_ST = 80 * MiB, SC_CB = 176 * MiB, SC_PD = 208 * MiB;
constexpr size_t SC_W = 0, SC_KK = 64 * MiB, SC_B = 96 * MiB, SC_Y = 128 * MiB;
constexpr size_t MS_BND = 0, MS_AGG = 4325376, MS_BS = MS_AGG + 1048576, MS_CDEC = MS_BS + 1048576, MS_BAR = MS_CDEC + 12288, BAR_BYTES = 3456 * 4, MS_SS1 = MS_BAR + BAR_BYTES, MS_SS2 = MS_SS1 + 131072;
constexpr size_t SC_HB2 = 0, SC_SSP2 = 64 * MiB, SC_SSP1 = 66 * MiB;
__device__ __forceinline__ float row_rstd(const float* ssp, int row) { const float4* p = (const float4*)(ssp + (size_t)row * 16); const float4 a = p[0], b = p[1], c = p[2], d = p[3];
    const float s = ((a.x + a.y) + (a.z + a.w)) + ((b.x + b.y) + (b.z + b.w)) + ((c.x + c.y) + (c.z + c.w)) + ((d.x + d.y) + (d.z + d.w)); return rsqrtf(s * (1.0f / 1024.0f) + 1e-6f); }
constexpr size_t SC_UNUSED_ = 0;

#define LAS __attribute__((address_space(3)))
struct Params { const float* in[NIN]; float* out; unsigned char* ws; int ph_lo, ph_hi; };
struct InArr { const Params* p; int z; __device__ __forceinline__ const float* operator[](int k) const { return p->in[k + z]; } };
struct Ctx { InArr in; float* out; unsigned char* ws; };

__device__ __forceinline__ int ltid() { int t = threadIdx.x; asm volatile("" : "+v"(t)); return t; }
__device__ __forceinline__ int lbid() { int t = blockIdx.x; asm volatile("" : "+s"(t)); return t; }
__device__ __forceinline__ int lnb() { int t = gridDim.x; asm volatile("" : "+s"(t)); return t; }
__device__ __forceinline__ float bf2f(bf16_t b) { return __uint_as_float(((unsigned)b) << 16); }
typedef __bf16 bf16x2_nat __attribute__((ext_vector_type(2)));
__device__ __forceinline__ unsigned pack2(float lo, float hi) { bf16x2_nat v; v.x = (__bf16)lo; v.y = (__bf16)hi; return __builtin_bit_cast(unsigned, v); }
__device__ __forceinline__ bf16_t f2bf(float f) { return __builtin_bit_cast(bf16_t, (__bf16)f); }
__device__ __forceinline__ float wave_sum(float v) {
#pragma unroll
    for (int o = 32; o >= 1; o >>= 1) v += __shfl_xor(v, o);
    return v;
}
__device__ __forceinline__ float rcpf_(float x) { return __builtin_amdgcn_rcpf(x); }
__device__ __forceinline__ float sigmoidf_(float x) { return rcpf_(1.0f + __expf(-x)); }
__device__ __forceinline__ float siluf_(float x) { return x * rcpf_(1.0f + __expf(-x)); }
__device__ __forceinline__ float softplusf_(float x) { return fmaxf(x, 0.0f) + __logf(1.0f + __expf(-fabsf(x))); }
__device__ __forceinline__ float tanhf_(float x) { return 1.0f - 2.0f * rcpf_(1.0f + __expf(2.0f * x)); }
__device__ __forceinline__ float gelu_tanh_(float x) { const float u = 0.7978845608028654f * (x + 0.044715f * x * x * x); return 0.5f * x * (1.0f + tanhf_(u)); }
__device__ __forceinline__ float row16_sum(float x) {
    x += __builtin_bit_cast(float, __builtin_amdgcn_update_dpp(0, __builtin_bit_cast(int, x), 0xB1, 0xF, 0xF, true));
    x += __builtin_bit_cast(float, __builtin_amdgcn_update_dpp(0, __builtin_bit_cast(int, x), 0x4E, 0xF, 0xF, true));
    x += __builtin_bit_cast(float, __builtin_amdgcn_update_dpp(0, __builtin_bit_cast(int, x), 0x141, 0xF, 0xF, true));
    x += __builtin_bit_cast(float, __builtin_amdgcn_update_dpp(0, __builtin_bit_cast(int, x), 0x140, 0xF, 0xF, true));
    return x;
}
__device__ __forceinline__ float bflo(unsigned w) { return __uint_as_float(w << 16); }
__device__ __forceinline__ float bfhi(unsigned w) { return __uint_as_float(w & 0xffff0000u); }
typedef short bf16x8_t __attribute__((ext_vector_type(8)));
typedef float f32x16_t __attribute__((ext_vector_type(16)));
__device__ __forceinline__ uint4 pack8(const float* v) { uint4 o; o.x = pack2(v[0], v[1]); o.y = pack2(v[2], v[3]); o.z = pack2(v[4], v[5]); o.w = pack2(v[6], v[7]); return o; }
__device__ __forceinline__ void unpack8(const uint4 r, float* v) { v[0] = bflo(r.x); v[1] = bfhi(r.x); v[2] = bflo(r.y); v[3] = bfhi(r.y); v[4] = bflo(r.z); v[5] = bfhi(r.z); v[6] = bflo(r.w); v[7] = bfhi(r.w); }
__device__ __forceinline__ float half32_sum(float x) { x = row16_sum(x); return x + __shfl_xor(x, 16); }

namespace pg8 {
#define PG8_LAS __attribute__((address_space(3)))
typedef unsigned short bf16_t;
typedef short bf16x8 __attribute__((ext_vector_type(8)));
typedef float f32x4 __attribute__((ext_vector_type(4)));
typedef unsigned u32x4 __attribute__((ext_vector_type(4)));
constexpr int BM = 256, BK = 64, HALF = 128, HTB = HALF * BK * 2  , STAGE_BYTES = 8 * HTB, NXCD = 8, WGM = 8;

__host__ __device__ __forceinline__ int lds_byte(int r, int c) { const int st = (r >> 4) * 2 + (c >> 5), rr = r & 15, cc = c & 31, ob = rr * 64 + cc * 2; return st * 1024 + (ob ^ (((ob >> 9) & 1) << 5)); }
__host__ __device__ __forceinline__ void stage_rc(int b, int& R, int& C) { const int st = b / 1024, sb = b % 1024, swz = sb ^ (((sb >> 9) & 1) << 5); R = (st >> 1) * 16 + swz / 64; C = (st & 1) * 32 + (swz % 64) / 2; }
__host__ __device__ __forceinline__ int perm32(int rho) { const int n = rho >> 4, i = rho & 15; return 8 * (i >> 2) + 4 * n + (i & 3); }

struct Unit { int pm, pn; };
struct Gemm { const bf16_t* A; const bf16_t* Bt; int M, N, K; };

struct StaticOrder {
    int nM, nN, nwg, G, c;
    __host__ __device__ void init(int M, int N, int G_, int c_) { nM = M / BM; nN = N / BM; nwg = nM * nN; G = G_; c = c_; }
    __host__ __device__ bool next(int i, Unit& u) const {
        const long L = (long)i * G + c; if (L >= nwg) return false;
        int wgid = (int)L; { const int q = nwg / NXCD, r = nwg % NXCD, xcd = wgid % NXCD, off = wgid / NXCD; wgid = (xcd < r ? xcd * (q + 1) : r * (q + 1) + (xcd - r) * q) + off; }
        const int nig = WGM * nN, gid = wgid / nig, fm = gid * WGM, gsz = (nM - fm) < WGM ? (nM - fm) : WGM;
        u.pm = fm + ((wgid % nig) % gsz); u.pn = (wgid % nig) / gsz; return true;
    }
    __device__ __forceinline__ void a_ready(const Unit&) const {}
    __device__ __forceinline__ void done(const Unit&) const {}
};
__device__ __forceinline__ unsigned cvt_pk_bf16(float lo, float hi) { unsigned r; asm volatile("v_cvt_pk_bf16_f32 %0, %1, %2" : "=v"(r) : "v"(lo), "v"(hi)); return r; }
typedef float f32x2 __attribute__((ext_vector_type(2)));
template <class Epi, class Sched, bool STAMP = false>
__device__ __forceinline__ void gemm_phase(PG8_LAS unsigned char* lds, const Gemm g, const Sched& S, const Epi& E, unsigned long long* stamps) {
    const int tid = ltid(), wid = __builtin_amdgcn_readfirstlane(tid >> 6), lane = tid & 63, wr = wid >> 2, wc = wid & 3, fr = lane & 15, fq = lane >> 4;
    const int K = g.K, nt = K / BK;
    int ts_lo = 0, ts_hi = 0, nts = 0; const unsigned long long rt_entry = STAMP ? (unsigned long long)wall_clock64() : 0ull;
#define PG8_STAMP() do { if (STAMP && wid == 0 && nts < 64) { const unsigned long long _c = (unsigned long long)clock64(); \
        ts_lo = (lane == nts) ? (int)(unsigned)_c : ts_lo; ts_hi = (lane == nts) ? (int)(unsigned)(_c >> 32) : ts_hi; ++nts; } } while (0)
    PG8_STAMP();
    unsigned voffA[2], voffB[2];
#pragma unroll
    for (int i = 0; i < 2; ++i) { int R, C; stage_rc(tid * 16 + i * 8192, R, C); const int Rb = Epi::PERM ? ((R & ~31) + perm32(R & 31)) : R;
        voffA[i] = (unsigned)(R * K + C) * 2u; voffB[i] = (unsigned)(Rb * K + C) * 2u; }
    const size_t kstep = (size_t)(BK * 2);
    const size_t hstep = (size_t)HALF * K * 2;
    const size_t tstep = 2 * hstep;
    const unsigned ldsw = (unsigned)wid * 1024u;
    const int aoff = lds_byte(wr * 64 + fr, fq * 8), boff = lds_byte(wc * 32 + fr, fq * 8);
#define PG8_SA(b, h) (((b) * 2 + (h)) * HTB)
#define PG8_SB(b, h) ((4 + (b) * 2 + (h)) * HTB)
#define PG8_STAGE(bufoff, gbase, voff) do { _Pragma("unroll") for (int _i = 0; _i < 2; ++_i) \
        __builtin_amdgcn_global_load_lds((const unsigned*)((const char*)(gbase) + (voff)[_i]), (PG8_LAS unsigned*)(lds + (bufoff) + ldsw + _i * 8192), 16, 0, 0); } while (0)
#define PG8_LDA(dst, b, h) do { _Pragma("unroll") for (int m = 0; m < 4; ++m) _Pragma("unroll") for (int k = 0; k < 2; ++k) dst[m][k] = *(const PG8_LAS bf16x8*)(lds + PG8_SA(b, h) + aoff + m * 2048 + k * 1024); } while (0)
#define PG8_LDB(dst, b, h) do { _Pragma("unroll") for (int n = 0; n < 2; ++n) _Pragma("unroll") for (int k = 0; k < 2; ++k) dst[n][k] = *(const PG8_LAS bf16x8*)(lds + PG8_SB(b, h) + boff + n * 2048 + k * 1024); } while (0)
#define PG8_MMA(ai, bj, At, Bt) do { __builtin_amdgcn_s_setprio(1); _Pragma("unroll") for (int m = 0; m < 4; ++m) _Pragma("unroll") for (int n = 0; n < 2; ++n) _Pragma("unroll") for (int k = 0; k < 2; ++k) \
        acc[ai][bj][m][n] = __builtin_amdgcn_mfma_f32_16x16x32_bf16(Bt[n][k], At[m][k], acc[ai][bj][m][n], 0, 0, 0); __builtin_amdgcn_s_setprio(0); } while (0)
#define PG8_WAIT_V(n) asm volatile("s_waitcnt vmcnt(" #n ")" ::: "memory")
#define PG8_WAIT_L(n) asm volatile("s_waitcnt lgkmcnt(" #n ")" ::: "memory")
#define PG8_BAR __builtin_amdgcn_s_barrier()
#define PG8_SCHED __builtin_amdgcn_sched_barrier(0)
    Unit cur, nxt; int ui = 0;
    if (!S.next(0, cur)) return;
    f32x4 acc[2][2][4][2];
#pragma unroll
    for (int a = 0; a < 2; ++a)
#pragma unroll
        for (int b = 0; b < 2; ++b)
#pragma unroll
            for (int m = 0; m < 4; ++m)
#pragma unroll
                for (int n = 0; n < 2; ++n) acc[a][b][m][n] = (f32x4){0.f, 0.f, 0.f, 0.f};
    bf16x8 At[4][2], B0[2][2], B1[2][2];
    const char* cA = (const char*)g.A + (size_t)cur.pm * tstep; const char* cB = (const char*)g.Bt + (size_t)cur.pn * tstep;
    S.a_ready(cur);
    PG8_STAGE(PG8_SB(0, 0), cB, voffB); PG8_STAGE(PG8_SA(0, 0), cA, voffA); PG8_STAGE(PG8_SB(0, 1), cB + hstep, voffB); PG8_STAGE(PG8_SA(0, 1), cA + hstep, voffA);
    if (wr == 1) PG8_BAR;
    PG8_WAIT_V(4); PG8_BAR;
    PG8_STAGE(PG8_SB(1, 0), cB + kstep, voffB); PG8_STAGE(PG8_SA(1, 0), cA + kstep, voffA); PG8_STAGE(PG8_SB(1, 1), cB + hstep + kstep, voffB);
    PG8_WAIT_V(6); PG8_BAR;
    PG8_STAMP();
    for (;;) {
        const bool has_next = S.next(ui + 1, nxt);
        const char* nA = has_next ? (const char*)g.A + (size_t)nxt.pm * tstep : cA; const char* nB = has_next ? (const char*)g.Bt + (size_t)nxt.pn * tstep : cB;
        for (int t = 0; t < nt; t += 2) {
            const bool last = (t == nt - 2);
            const char* a1 = cA + (size_t)(t + 1) * kstep;
            const char* a2 = last ? nA : cA + (size_t)(t + 2) * kstep; const char* b2 = last ? nB : cB + (size_t)(t + 2) * kstep;
            const char* a3 = a2 + kstep; const char* b3 = b2 + kstep;
            if (last && has_next) S.a_ready(nxt);
            PG8_LDB(B0, 0, 0); PG8_SCHED; PG8_LDA(At, 0, 0); PG8_STAGE(PG8_SA(1, 1), a1 + hstep, voffA);
            PG8_WAIT_L(8); PG8_BAR; PG8_WAIT_L(0); PG8_MMA(0, 0, At, B0); PG8_BAR; PG8_SCHED;
            PG8_LDB(B1, 0, 1); PG8_STAGE(PG8_SB(0, 0), b2, voffB);
            PG8_BAR; PG8_WAIT_L(0); PG8_MMA(0, 1, At, B1); PG8_BAR;
            PG8_LDA(At, 0, 1); PG8_STAGE(PG8_SA(0, 0), a2, voffA);
            PG8_BAR; PG8_WAIT_L(0); PG8_MMA(1, 0, At, B0); PG8_BAR; PG8_SCHED;
            PG8_STAGE(PG8_SB(0, 1), b2 + hstep, voffB);
            PG8_WAIT_V(6); PG8_BAR; PG8_MMA(1, 1, At, B1); PG8_BAR;
            PG8_LDB(B0, 1, 0); PG8_SCHED; PG8_LDA(At, 1, 0); PG8_STAGE(PG8_SA(0, 1), a2 + hstep, voffA);
            PG8_WAIT_L(8); PG8_BAR; PG8_WAIT_L(0); PG8_MMA(0, 0, At, B0); PG8_BAR; PG8_SCHED;
            PG8_LDB(B1, 1, 1); PG8_STAGE(PG8_SB(1, 0), b3, voffB);
            PG8_BAR; PG8_WAIT_L(0); PG8_MMA(0, 1, At, B1); PG8_BAR;
            PG8_LDA(At, 1, 1); PG8_STAGE(PG8_SA(1, 0), a3, voffA);
            PG8_BAR; PG8_WAIT_L(0); PG8_MMA(1, 0, At, B0); PG8_BAR; PG8_SCHED;
            PG8_STAGE(PG8_SB(1, 1), b3 + hstep, voffB);
            PG8_WAIT_V(6); PG8_BAR; PG8_MMA(1, 1, At, B1); PG8_BAR;
        }
        PG8_STAMP();
        if constexpr (!Epi::AFTER_DRAIN) { E(acc, cur, wr, wc, fr, fq); S.done(cur); }
        PG8_STAMP();
        if (!has_next) break;
#pragma unroll
        for (int a = 0; a < 2; ++a)
#pragma unroll
            for (int b = 0; b < 2; ++b)
#pragma unroll
                for (int m = 0; m < 4; ++m)
#pragma unroll
                    for (int n = 0; n < 2; ++n) acc[a][b][m][n] = (f32x4){0.f, 0.f, 0.f, 0.f};
        cur = nxt; cA = nA; cB = nB; ++ui;
    }
    PG8_WAIT_V(0);
    if (wr == 0) PG8_BAR;
    PG8_BAR;
    if constexpr (Epi::AFTER_DRAIN) { E.fused(acc, cur, wr, wc, fr, fq, lds, wid, lane); S.done(cur); }
    PG8_STAMP();
    if (STAMP && wid == 0) { stamps[lane] = lane < nts ? (((unsigned long long)(unsigned)ts_hi << 32) | (unsigned)ts_lo) : 0ull;
        if (lane == 62) stamps[62] = rt_entry; if (lane == 63) stamps[63] = (unsigned long long)wall_clock64(); }
#undef PG8_STAMP
#undef PG8_SA
#undef PG8_SB
#undef PG8_STAGE
#undef PG8_LDA
#undef PG8_LDB
#undef PG8_MMA
#undef PG8_WAIT_V
#undef PG8_WAIT_L
#undef PG8_BAR
#undef PG8_SCHED
}
}

typedef unsigned u32x4_t __attribute__((ext_vector_type(4)));
typedef unsigned u32x2_t __attribute__((ext_vector_type(2)));
struct EpiP {
    static constexpr bool PERM = true, AFTER_DRAIN = false;
    bf16_t* O; bf16_t* bnd; const float* ss;
    __device__ __forceinline__ void operator()(const pg8::f32x4 (&acc)[2][2][4][2], const pg8::Unit& u, int wr, int wc, int fr, int fq) const {
        const int row0 = u.pm * 256 + wr * 64 + fr, col0 = u.pn * 256 + wc * 32 + 8 * fq;
        float rsv[2][4];
#pragma unroll
        for (int ai = 0; ai < 2; ++ai)
#pragma unroll
            for (int m = 0; m < 4; ++m) rsv[ai][m] = ss[row0 + ai * 128 + m * 16];
#pragma unroll
        for (int ai = 0; ai < 2; ++ai)
#pragma unroll
            for (int m = 0; m < 4; ++m) { const int row = row0 + ai * 128 + m * 16; bf16_t* rowp = O + (size_t)row * PP + col0; const float rs = rsv[ai][m];
#pragma unroll
                for (int bj = 0; bj < 2; ++bj) { const pg8::f32x4 v0 = acc[ai][bj][m][0] * rs, v1 = acc[ai][bj][m][1] * rs;
                    u32x4_t w; w.x = pack2(v0[0], v0[1]); w.y = pack2(v0[2], v0[3]); w.z = pack2(v1[0], v1[1]); w.w = pack2(v1[2], v1[3]);
                    *(u32x4_t*)(rowp + bj * 128) = w;
                    if (bnd && (row & 127) >= 125) *(u32x4_t*)(bnd + ((size_t)(row >> 7) * 3 + (row & 127) - 125) * PP + col0 + bj * 128) = w; } }
    }
};
struct EpiRes {
    static constexpr bool PERM = true, AFTER_DRAIN = false;
    const bf16_t* hin; bf16_t* hout; float* ss;
    __device__ __forceinline__ void operator()(const pg8::f32x4 (&acc)[2][2][4][2], const pg8::Unit& u, int wr, int wc, int fr, int fq) const {
        const int row0 = u.pm * 256 + wr * 64 + fr, col0 = u.pn * 256 + wc * 32 + 8 * fq;
#pragma unroll
        for (int ai = 0; ai < 2; ++ai) {
            u32x4_t bv[4][2];
#pragma unroll
            for (int m = 0; m < 4; ++m)
#pragma unroll
                for (int bj = 0; bj < 2; ++bj) bv[m][bj] = *(const u32x4_t*)(hin + (size_t)(row0 + ai * 128 + m * 16) * DM + col0 + bj * 128);
#pragma unroll
            for (int m = 0; m < 4; ++m) { const int row = row0 + ai * 128 + m * 16; float sq = 0.f;
#pragma unroll
                for (int bj = 0; bj < 2; ++bj) { const u32x4_t r = bv[m][bj]; const pg8::f32x4 a0 = acc[ai][bj][m][0], a1 = acc[ai][bj][m][1];
                    const float v0 = bflo(r.x) + a0[0], v1 = bfhi(r.x) + a0[1], v2 = bflo(r.y) + a0[2], v3 = bfhi(r.y) + a0[3], v4 = bflo(r.z) + a1[0], v5 = bfhi(r.z) + a1[1], v6 = bflo(r.w) + a1[2], v7 = bfhi(r.w) + a1[3];
                    u32x4_t w; w.x = pack2(v0, v1); w.y = pack2(v2, v3); w.z = pack2(v4, v5); w.w = pack2(v6, v7);
                    *(u32x4_t*)(hout + (size_t)row * DM + col0 + bj * 128) = w;
                    sq += (v0 * v0 + v1 * v1) + (v2 * v2 + v3 * v3) + (v4 * v4 + v5 * v5) + (v6 * v6 + v7 * v7); }
                sq += __shfl_xor(sq, 16); sq += __shfl_xor(sq, 32);
                if (fq == 0) ss[(size_t)row * 16 + u.pn * 4 + wc] = sq; }
            asm volatile("" ::: "memory"); }
    }
};
struct EpiSwi {
    static constexpr bool PERM = true, AFTER_DRAIN = false;
    bf16_t* O; const float* ss;
    __device__ __forceinline__ void operator()(const pg8::f32x4 (&acc)[2][2][4][2], const pg8::Unit& u, int wr, int wc, int fr, int fq) const {
        const int row0 = u.pm * 256 + wr * 64 + fr, col0 = u.pn * 256 + wc * 32 + 8 * fq;
        float rsv[2][4];
#pragma unroll
        for (int ai = 0; ai < 2; ++ai)
#pragma unroll
            for (int m = 0; m < 4; ++m) rsv[ai][m] = ss[row0 + ai * 128 + m * 16];
#pragma unroll
        for (int ai = 0; ai < 2; ++ai)
#pragma unroll
            for (int m = 0; m < 4; ++m) { const int row = row0 + ai * 128 + m * 16; bf16_t* rowp = O + (size_t)row * PP + (col0 >> 1); const float rs = rsv[ai][m];
#pragma unroll
                for (int bj = 0; bj < 2; ++bj) { const pg8::f32x4 g = acc[ai][bj][m][0] * rs, up = acc[ai][bj][m][1] * rs;
                    u32x2_t w; w.x = pack2(siluf_(g[0]) * up[0], siluf_(g[1]) * up[1]); w.y = pack2(siluf_(g[2]) * up[2], siluf_(g[3]) * up[3]);
                    *(u32x2_t*)(rowp + bj * 64) = w; } }
    }
};

struct ColSrc { const float* p; int ld; };
__device__ __forceinline__ ColSrc col_src(const Ctx& P, int layer, int mat, int r) {
    const int i = layer >> 1; const bool odd = layer & 1;
    ColSrc c; c.p = nullptr; c.ld = 0;
    if (mat == 0) { if (odd) { c.p = P.in[17] + (size_t)i * 1024 * 2816 + r; c.ld = 2816; } else if (r < 2316) { c.p = P.in[7] + (size_t)i * 1024 * 2316 + r; c.ld = 2316; } }
    else if (mat == 1) { c.p = (odd ? P.in[18] : P.in[8]) + (size_t)i * 1024 * 1024 + r; c.ld = 1024; }
    else if (mat == 2) { const int q = r >> 3, j = r & 7, f = 4 * q + (j & 3); c.p = (j < 4 ? P.in[3] : P.in[4]) + (size_t)layer * 1024 * 2816 + f; c.ld = 2816; }
    else { c.p = P.in[5] + (size_t)layer * 2816 * 1024 + r; c.ld = 1024; }
    return c;
}
struct ConvTile { int mat, rt, kt, K; bf16_t* dst; };
__device__ __forceinline__ ConvTile conv_tile(const Ctx& P, int tile, int n0, int n1, int n2) {
    ConvTile c;
    if (tile < n0) { c.mat = 0; c.K = 1024; c.rt = tile / 16; c.kt = tile % 16; c.dst = (bf16_t*)(P.ws + WS_WIN); }
    else if (tile < n0 + n1) { const int x = tile - n0; c.mat = 1; c.K = 1024; c.rt = x / 16; c.kt = x % 16; c.dst = (bf16_t*)(P.ws + WS_WOUT); }
    else if (tile < n0 + n1 + n2) { const int x = tile - n0 - n1; c.mat = 2; c.K = 1024; c.rt = x / 16; c.kt = x % 16; c.dst = (bf16_t*)(P.ws + WS_WGU); }
    else { const int x = tile - n0 - n1 - n2; c.mat = 3; c.K = 2816; c.rt = x / 44; c.kt = x % 44; c.dst = (bf16_t*)(P.ws + WS_WDN); }
    return c;
}
__device__ void phase_convert(const Ctx& P, int layer, unsigned char* shm) {
    float* T = (float*)shm;
    const bool odd = layer & 1; const int n0 = (odd ? 44 : 40) * 16, n1 = 256, n2 = 88 * 16, n3 = 16 * 44, ntot = n0 + n1 + n2 + n3;
    const int tid = ltid(), nblk = lnb();
    const int rr = tid & 63, kk = tid >> 6, r2 = tid >> 3, kq = tid & 7;
    for (int tile = lbid(); tile < ntot; tile += 2 * nblk) {
        const int tile2 = tile + nblk; const bool has2 = tile2 < ntot;
        const ConvTile c0 = conv_tile(P, tile, n0, n1, n2), c1 = conv_tile(P, has2 ? tile2 : tile, n0, n1, n2);
        const ColSrc s0 = col_src(P, layer, c0.mat, c0.rt * 64 + rr), s1 = col_src(P, layer, c1.mat, c1.rt * 64 + rr);
        const float* g0 = c0.mat == 0 ? P.in[1] + layer * DM : (c0.mat == 2 ? P.in[2] + layer * DM : nullptr);
        const float* g1 = c1.mat == 0 ? P.in[1] + layer * DM : (c1.mat == 2 ? P.in[2] + layer * DM : nullptr);
        float v0[8], v1[8];
#pragma unroll
        for (int k8 = 0; k8 < 8; ++k8) { const int k = k8 * 8 + kk;
            v0[k8] = s0.p ? s0.p[(size_t)(c0.kt * 64 + k) * s0.ld] * (g0 ? g0[c0.kt * 64 + k] : 1.0f) : 0.f;
            v1[k8] = s1.p ? s1.p[(size_t)(c1.kt * 64 + k) * s1.ld] * (g1 ? g1[c1.kt * 64 + k] : 1.0f) : 0.f; }
#pragma unroll
        for (int k8 = 0; k8 < 8; ++k8) { const int k = k8 * 8 + kk; T[k * 65 + rr] = v0[k8]; T[4160 + k * 65 + rr] = v1[k8]; }
        __syncthreads();
#pragma unroll
        for (int h2 = 0; h2 < 2; ++h2) { if (h2 == 1 && !has2) break; const int cK = h2 ? c1.K : c0.K, crt = h2 ? c1.rt : c0.rt, ckt = h2 ? c1.kt : c0.kt; bf16_t* cdst = h2 ? c1.dst : c0.dst; const float* Tt = T + h2 * 4160;
            uint4 w;
            w.x = pack2(Tt[(kq * 8 + 0) * 65 + r2], Tt[(kq * 8 + 1) * 65 + r2]); w.y = pack2(Tt[(kq * 8 + 2) * 65 + r2], Tt[(kq * 8 + 3) * 65 + r2]);
            w.z = pack2(Tt[(kq * 8 + 4) * 65 + r2], Tt[(kq * 8 + 5) * 65 + r2]); w.w = pack2(Tt[(kq * 8 + 6) * 65 + r2], Tt[(kq * 8 + 7) * 65 + r2]);
            *(uint4*)(cdst + (size_t)(crt * 64 + r2) * cK + ckt * 64 + kq * 8) = w; }
        __syncthreads();
    }
}

__device__ void phase_x_to_bf16(const float* h, bf16_t* out, float* ss) {
    const int lane = ltid() & 63, gw = lbid() * 8 + (ltid() >> 6), nw = lnb() * 8;
    for (int row = gw * 2; row < M_TOK; row += nw * 2) {
        const float4* p = (const float4*)(h + (size_t)row * DM);
        float4 v[8]; float s0 = 0.f, s1 = 0.f;
#pragma unroll
        for (int i = 0; i < 8; ++i) v[i] = p[lane + 64 * i];
#pragma unroll
        for (int i = 0; i < 4; ++i) { s0 += v[i].x * v[i].x + v[i].y * v[i].y + v[i].z * v[i].z + v[i].w * v[i].w; s1 += v[4 + i].x * v[4 + i].x + v[4 + i].y * v[4 + i].y + v[4 + i].z * v[4 + i].z + v[4 + i].w * v[4 + i].w; }
        s0 = wave_sum(s0); s1 = wave_sum(s1);
        if (lane == 0) { ss[row] = rsqrtf(s0 * (1.0f / 1024.0f) + 1e-6f); ss[row + 1] = rsqrtf(s1 * (1.0f / 1024.0f) + 1e-6f); }
#pragma unroll
        for (int i = 0; i < 8; ++i) { uint2 w; w.x = pack2(v[i].x, v[i].y); w.y = pack2(v[i].z, v[i].w); *(uint2*)(out + (size_t)row * DM + (lane + 64 * i) * 4) = w; }
    }
}
__device__ void phase_final_norm(const bf16_t* h, float* out, const float* g, const float* ss) {
    const int lane = ltid() & 63, gw = lbid() * 8 + (ltid() >> 6), nw = lnb() * 8;
    for (int row = gw * 2; row < M_TOK; row += nw * 2) {
        const float rs0 = row_rstd(ss, row), rs1 = row_rstd(ss, row + 1);
        uint4 hv[4];
#pragma unroll
        for (int i = 0; i < 4; ++i) hv[i] = *(const uint4*)(h + (size_t)row * DM + (lane + 64 * i) * 8);
#pragma unroll
        for (int i = 0; i < 4; ++i) { const int c8 = (lane + 64 * (i & 1)) * 8; float v[8]; unpack8(hv[i], v); const float rs = i < 2 ? rs0 : rs1;
            const float4 g0 = *(const float4*)(g + c8), g1 = *(const float4*)(g + c8 + 4); float4 o0, o1;
            o0.x = v[0] * rs * g0.x; o0.y = v[1] * rs * g0.y; o0.z = v[2] * rs * g0.z; o0.w = v[3] * rs * g0.w; o1.x = v[4] * rs * g1.x; o1.y = v[5] * rs * g1.y; o1.z = v[6] * rs * g1.z; o1.w = v[7] * rs * g1.w;
            float* op = out + (size_t)(row + (i >> 1)) * DM + c8; *(float4*)op = o0; *(float4*)(op + 4) = o1; }
    }
}
__device__ void finalize_rstd(const float* ssp, float* rstd) { for (int i = lbid() * 512 + ltid(); i < M_TOK; i += lnb() * 512) rstd[i] = row_rstd(ssp, i); }

__device__ __forceinline__ float* tokaux(bf16_t* Pb, int t) { return (float*)(Pb + (size_t)t * PP + 2560); }

__device__ void phase_even_prep(const Ctx& P, int layer) {
    const int i = layer >> 1;
    bf16_t* Pb = (bf16_t*)(P.ws + WS_P);
    bf16_t* XBC = (bf16_t*)(P.ws + WS_SC + SC_XBC);
    float* PD = (float*)(P.ws + WS_SC + SC_PD);
    const float* cw = P.in[11] + (size_t)i * 4 * 1280; const float* cb = P.in[12] + i * 1280; const float* dtb = P.in[13] + i * 12;
    const int gt = lbid() * 512 + ltid(), gs = lnb() * 512;
    for (int idx = gt; idx < 160 * 1024; idx += gs) {
        const int cg = idx % 160, run = idx / 160, c8 = cg * 8, tstart = run * 32;
        float wk[4][8], bias[8];
#pragma unroll
        for (int k = 0; k < 4; ++k) { const float4 a = *(const float4*)(cw + k * 1280 + c8), c = *(const float4*)(cw + k * 1280 + c8 + 4); wk[k][0] = a.x; wk[k][1] = a.y; wk[k][2] = a.z; wk[k][3] = a.w; wk[k][4] = c.x; wk[k][5] = c.y; wk[k][6] = c.z; wk[k][7] = c.w; }
        { const float4 a = *(const float4*)(cb + c8), c = *(const float4*)(cb + c8 + 4); bias[0] = a.x; bias[1] = a.y; bias[2] = a.z; bias[3] = a.w; bias[4] = c.x; bias[5] = c.y; bias[6] = c.z; bias[7] = c.w; }
        float h1[8], h2[8], h3[8];
        { const bool first = (tstart & (SEQ - 1)) == 0; const int back = first ? 0 : 1;
          const uint4 r1 = *(const uint4*)(Pb + (size_t)(tstart - back) * PP + 1024 + c8), r2 = *(const uint4*)(Pb + (size_t)(tstart - 2 * back) * PP + 1024 + c8), r3 = *(const uint4*)(Pb + (size_t)(tstart - 3 * back) * PP + 1024 + c8);
          unpack8(r1, h1); unpack8(r2, h2); unpack8(r3, h3);
          const float keep = first ? 0.f : 1.f;
#pragma unroll
          for (int j = 0; j < 8; ++j) { h1[j] *= keep; h2[j] *= keep; h3[j] *= keep; } }
#pragma unroll
        for (int tb = 0; tb < 32; tb += 8) {
            uint4 raw[8];
#pragma unroll
            for (int q = 0; q < 8; ++q) raw[q] = *(const uint4*)(Pb + (size_t)(tstart + tb + q) * PP + 1024 + c8);
#pragma unroll
            for (int q = 0; q < 8; ++q) { float x[8], o[8]; unpack8(raw[q], x);
#pragma unroll
                for (int j = 0; j < 8; ++j) { o[j] = siluf_(bias[j] + wk[0][j] * h3[j] + wk[1][j] * h2[j] + wk[2][j] * h1[j] + wk[3][j] * x[j]); h3[j] = h2[j]; h2[j] = h1[j]; h1[j] = x[j]; }
                *(uint4*)(XBC + (size_t)(tstart + tb + q) * 1280 + c8) = pack8(o); }
        }
    }
    for (int idx = gt; idx < M_TOK * 12; idx += gs) { const int t = idx / 12, e = idx % 12; tokaux(Pb, t)[e] = softplusf_(bf2f(Pb[(size_t)t * PP + 2304 + e]) + dtb[e]); }
    for (int idx = gt; idx < M_TOK * 32; idx += gs) {
        const int t = idx >> 5, c8 = (idx & 31) * 8, g = c8 >> 6, w = 2 << g, tp = t & (SEQ - 1), cnt = (tp + 1 < w) ? tp + 1 : w;
        float s[8], u[8];
#pragma unroll
        for (int j = 0; j < 8; ++j) { s[j] = 0.f; u[j] = 0.f; }
        uint4 rw[16];
#pragma unroll
        for (int q = 0; q < 16; ++q) { const int qq = q < cnt ? q : 0; rw[q] = *(const uint4*)(Pb + (size_t)(t - qq) * PP + c8); }
#pragma unroll
        for (int q = 0; q < 16; ++q) { const uint4 raw = rw[q]; const float m = q < cnt ? 1.0f : 0.0f;
            const float v0 = bflo(raw.x), v1 = bfhi(raw.x), v2 = bflo(raw.y), v3 = bfhi(raw.y), v4 = bflo(raw.z), v5 = bfhi(raw.z), v6 = bflo(raw.w), v7 = bfhi(raw.w);
            s[0] += m * v0; s[1] += m * v1; s[2] += m * v2; s[3] += m * v3; s[4] += m * v4; s[5] += m * v5; s[6] += m * v6; s[7] += m * v7;
            if (q == 0) { u[0] = v0; u[1] = v1; u[2] = v2; u[3] = v3; u[4] = v4; u[5] = v5; u[6] = v6; u[7] = v7; } }
        const float inv = 1.0f / (float)cnt;
        float4 d0, d1; d0.x = s[0] * inv - u[0]; d0.y = s[1] * inv - u[1]; d0.z = s[2] * inv - u[2]; d0.w = s[3] * inv - u[3]; d1.x = s[4] * inv - u[4]; d1.y = s[5] * inv - u[5]; d1.z = s[6] * inv - u[6]; d1.w = s[7] * inv - u[7];
        *(float4*)(PD + (size_t)t * 256 + c8) = d0; *(float4*)(PD + (size_t)t * 256 + c8 + 4) = d1;
    }
}

__device__ void phase_even_states(const Ctx& P, int layer, unsigned char* shm) {
    const int i = layer >> 1, tid = ltid();
    bf16_t* Pb = (bf16_t*)(P.ws + WS_P); bf16_t* YM = (bf16_t*)P.out;
    const bf16_t* XBC = (const bf16_t*)(P.ws + WS_SC + SC_XBC);
    const float* PD = (const float*)(P.ws + WS_SC + SC_PD);
    bf16_t* ST = (bf16_t*)(P.ws + WS_SC + SC_ST); float* CDEC = (float*)(P.ws + WS_MISC + MS_CDEC);
    {
        float* T = (float*)shm;
        const float* pw = P.in[9] + (size_t)i * 4 * 64 * 64; const float* psc = P.in[10] + i * 256;
        const int col = tid & 255, half = tid >> 8, g = col >> 6, j = col & 63;
        float wreg[64];
#pragma unroll
        for (int c = 0; c < 64; ++c) wreg[c] = pw[(g * 64 + c) * 64 + j];
        const float sc = psc[col];
        for (int unit = lbid(); unit < 512; unit += lnb()) {
            const int t0 = unit * 64;
#pragma unroll
            for (int q = 0; q < 8; ++q) { const int i4 = q * 512 + tid; ((float4*)T)[i4] = ((const float4*)(PD + (size_t)t0 * 256))[i4]; }
            __syncthreads();
            for (int tt = 0; tt < 32; ++tt) { const int tok = half * 32 + tt; const float4* row = (const float4*)(T + tok * 256 + g * 64); float acc = 0.f;
#pragma unroll
                for (int c4 = 0; c4 < 16; ++c4) { const float4 d = row[c4]; acc += d.x * wreg[4 * c4] + d.y * wreg[4 * c4 + 1] + d.z * wreg[4 * c4 + 2] + d.w * wreg[4 * c4 + 3]; }
                YM[(size_t)(t0 + tok) * DM + col] = f2bf(acc * sc); }
            __syncthreads();
        }
    }
    {
        bf16_t* Bm = (bf16_t*)shm;
        bf16_t* Cm = Bm + 128 * 136;
        bf16_t* BmT = Cm + 128 * 136;
        bf16_t* XST = BmT + 128 * 136;
        float* cum = (float*)(XST + 64 * 136); float* dts = cum + 768;
        const float* alog = P.in[14] + i * 12;
        const int wave = __builtin_amdgcn_readfirstlane(tid >> 6), lane = tid & 63, hf = lane >> 5, l31 = lane & 31;
        for (int unit = lbid(); unit < 512; unit += lnb()) {
            const int b = unit >> 8, c = (unit >> 1) & 127, g = unit & 1, t0 = b * SEQ + c * 128;
            __syncthreads();
#pragma unroll
            for (int idx = tid; idx < 128 * 16; idx += 512) { const int l = idx >> 4, n8 = (idx & 15) * 8;
                const uint4 rb = *(const uint4*)(XBC + (size_t)(t0 + l) * 1280 + 768 + g * 128 + n8);
                BmT[(n8 + 0) * 136 + l] = (bf16_t)(rb.x & 0xffffu); BmT[(n8 + 1) * 136 + l] = (bf16_t)(rb.x >> 16); BmT[(n8 + 2) * 136 + l] = (bf16_t)(rb.y & 0xffffu); BmT[(n8 + 3) * 136 + l] = (bf16_t)(rb.y >> 16);
                BmT[(n8 + 4) * 136 + l] = (bf16_t)(rb.z & 0xffffu); BmT[(n8 + 5) * 136 + l] = (bf16_t)(rb.z >> 16); BmT[(n8 + 6) * 136 + l] = (bf16_t)(rb.w & 0xffffu); BmT[(n8 + 7) * 136 + l] = (bf16_t)(rb.w >> 16); }
            for (int idx = tid; idx < 768; idx += 512) dts[idx] = tokaux(Pb, t0 + (idx & 127))[g * 6 + (idx >> 7)];
            __syncthreads();
            if (tid < 6) { const float a = -__expf(alog[g * 6 + tid]); float cs = 0.f;
#pragma unroll 8
                for (int l = 0; l < 128; ++l) { cs += dts[tid * 128 + l] * a; cum[tid * 128 + l] = cs; } }
            __syncthreads();
            for (int idx = tid; idx < 768; idx += 512) tokaux(Pb, t0 + (idx & 127))[12 + g * 6 + (idx >> 7)] = cum[idx];
            for (int e = 0; e < 6; ++e) { const int hh = g * 6 + e; const float cl = cum[e * 128 + 127];
                __syncthreads();
#pragma unroll
                for (int q = 0; q < 2; ++q) { const int item = tid + 512 * q, l = item >> 3, p8 = (item & 7) * 8;
                    const uint4 rx = *(const uint4*)(XBC + (size_t)(t0 + l) * 1280 + hh * 64 + p8); float x[8]; unpack8(rx, x);
                    const float sc = dts[e * 128 + l] * __expf(cl - cum[e * 128 + l]);
#pragma unroll
                    for (int j = 0; j < 8; ++j) XST[(p8 + j) * 136 + l] = f2bf(x[j] * sc); }
                __syncthreads();
                { const int pi = wave >> 2, ni = wave & 3; f32x16_t acc;
#pragma unroll
                  for (int q = 0; q < 16; ++q) acc[q] = 0.f;
#pragma unroll
                  for (int ks = 0; ks < 8; ++ks) { const int k = ks * 16 + 8 * hf;
                      const bf16x8_t fa = *(const bf16x8_t*)(XST + (pi * 32 + l31) * 136 + k), fb = *(const bf16x8_t*)(BmT + (ni * 32 + l31) * 136 + k); acc = __builtin_amdgcn_mfma_f32_32x32x16_bf16(fa, fb, acc, 0, 0, 0); }
                  bf16_t* so = ST + ((size_t)(b * 128 + c) * 12 + hh) * 8192 + (pi * 32 + 4 * hf) * 128 + ni * 32 + l31;
#pragma unroll
                  for (int q = 0; q < 16; ++q) so[((q & 3) + 8 * (q >> 2)) * 128] = f2bf(acc[q]); }
                if (tid == 0) CDEC[(b * 128 + c) * 12 + hh] = __expf(cl);
            }
        }
    }
}

__device__ void phase_even_pass(const Ctx& P) {
    bf16_t* ST = (bf16_t*)(P.ws + WS_SC + SC_ST); const float* CDEC = (const float*)(P.ws + WS_MISC + MS_CDEC);
    for (int gt = lbid() * 512 + ltid(); gt < 98304; gt += lnb() * 512) {
        const int b = gt / 49152, rem = gt % 49152, hh = rem >> 12, i2 = rem & 4095;
        float hx = 0.f, hy = 0.f;
        unsigned st[16], st2[16]; float dec[16], dec2[16];
#pragma unroll
        for (int q = 0; q < 16; ++q) { const size_t o = ((size_t)(b * 128 + q) * 12 + hh) * 8192 + i2 * 2; st[q] = *(const unsigned*)(ST + o); dec[q] = CDEC[(b * 128 + q) * 12 + hh]; }
        for (int c0 = 0; c0 < 128; c0 += 16) {
            const int cn = c0 + 16 < 128 ? c0 + 16 : c0;
#pragma unroll
            for (int q = 0; q < 16; ++q) { const size_t o = ((size_t)(b * 128 + cn + q) * 12 + hh) * 8192 + i2 * 2; st2[q] = *(const unsigned*)(ST + o); dec2[q] = CDEC[(b * 128 + cn + q) * 12 + hh]; }
#pragma unroll
            for (int q = 0; q < 16; ++q) { const size_t o = ((size_t)(b * 128 + c0 + q) * 12 + hh) * 8192 + i2 * 2; *(unsigned*)(ST + o) = pack2(hx, hy); hx = hx * dec[q] + bflo(st[q]); hy = hy * dec[q] + bfhi(st[q]); }
#pragma unroll
            for (int q = 0; q < 16; ++q) { st[q] = st2[q]; dec[q] = dec2[q]; }
        }
    }
}

__device__ void phase_even_out(const Ctx& P, int layer, unsigned char* shm) {
    const int i = layer >> 1, tid = ltid(), wave = __builtin_amdgcn_readfirstlane(tid >> 6), lane = tid & 63, hf = lane >> 5, l31 = lane & 31;
    bf16_t* Pb = (bf16_t*)(P.ws + WS_P); bf16_t* YM = (bf16_t*)P.out;
    const bf16_t* XBC = (const bf16_t*)(P.ws + WS_SC + SC_XBC);
    const bf16_t* ST = (const bf16_t*)(P.ws + WS_SC + SC_ST);
    const float* dsk = P.in[15] + i * 12; const float* ng = P.in[16] + i * 768;
    bf16_t* Cm = (bf16_t*)shm;
    bf16_t* Mb = Cm + 128 * 136;
    bf16_t* XT = Mb + 128 * 136;
    bf16_t* PV = XT + 64 * 136;
    float* cumL = (float*)(PV + 64 * 136); float* dtL = cumL + 128; float* SSQ = dtL + 128;
    bf16_t* CBb = (bf16_t*)(SSQ + 256);
    const int li = wave >> 1, pi = wave & 1, p = pi * 32 + l31;
    for (int unit = lbid(); unit < 512; unit += lnb()) {
        const int b = unit >> 8, c = (unit >> 1) & 127, g = unit & 1, t0 = b * SEQ + c * 128;
        __syncthreads();
#pragma unroll
        for (int idx = tid; idx < 128 * 16; idx += 512) { const int l = idx >> 4, n8 = (idx & 15) * 8; *(uint4*)(Cm + l * 136 + n8) = *(const uint4*)(XBC + (size_t)(t0 + l) * 1280 + 1024 + g * 128 + n8);
            *(uint4*)(Mb + l * 136 + n8) = *(const uint4*)(XBC + (size_t)(t0 + l) * 1280 + 768 + g * 128 + n8); }
        __syncthreads();
        {
#pragma unroll
            for (int sj = 0; sj < 2; ++sj) { const int si = (wave & 1) * 2 + sj; f32x16_t acc;
#pragma unroll
                for (int q = 0; q < 16; ++q) acc[q] = 0.f;
#pragma unroll
                for (int ks = 0; ks < 8; ++ks) { const int k = ks * 16 + 8 * hf;
                    const bf16x8_t fa = *(const bf16x8_t*)(Cm + (li * 32 + l31) * 136 + k), fb = *(const bf16x8_t*)(Mb + (si * 32 + l31) * 136 + k); acc = __builtin_amdgcn_mfma_f32_32x32x16_bf16(fa, fb, acc, 0, 0, 0); }
#pragma unroll
                for (int q = 0; q < 16; ++q) CBb[(li * 32 + 4 * hf + (q & 3) + 8 * (q >> 2)) * 136 + si * 32 + l31] = f2bf(acc[q]); } }

        float ssq[16];
#pragma unroll
        for (int reg = 0; reg < 16; ++reg) ssq[reg] = 0.f;
#pragma unroll 1
        for (int e = 0; e < 6; ++e) {
            const int hh = g * 6 + e;
            __syncthreads();
            if (tid < 128) { const float* ax = tokaux(Pb, t0 + tid); cumL[tid] = ax[12 + hh]; dtL[tid] = ax[hh]; }
            __syncthreads();
#pragma unroll 2
            for (int q = 0; q < 4; ++q) { const int item = tid + 512 * q, l = item >> 4, s8 = (item & 15) * 8;
                float v[8]; unpack8(*(const uint4*)(CBb + l * 136 + s8), v); const float cl_ = cumL[l];
#pragma unroll
                for (int j = 0; j < 8; ++j) { const int s = s8 + j; v[j] = (s <= l) ? v[j] * __expf(fminf(cl_ - cumL[s], 0.f)) * dtL[s] : 0.f; }
                *(uint4*)(Mb + l * 136 + s8) = pack8(v); }
#pragma unroll
            for (int q = 0; q < 2; ++q) { const int item = tid + 512 * q, s = item >> 3, p8 = (item & 7) * 8;
                const uint4 rx = *(const uint4*)(XBC + (size_t)(t0 + s) * 1280 + hh * 64 + p8);
                XT[(p8 + 0) * 136 + s] = (bf16_t)(rx.x & 0xffffu); XT[(p8 + 1) * 136 + s] = (bf16_t)(rx.x >> 16); XT[(p8 + 2) * 136 + s] = (bf16_t)(rx.y & 0xffffu); XT[(p8 + 3) * 136 + s] = (bf16_t)(rx.y >> 16);
                XT[(p8 + 4) * 136 + s] = (bf16_t)(rx.z & 0xffffu); XT[(p8 + 5) * 136 + s] = (bf16_t)(rx.z >> 16); XT[(p8 + 6) * 136 + s] = (bf16_t)(rx.w & 0xffffu); XT[(p8 + 7) * 136 + s] = (bf16_t)(rx.w >> 16); }
#pragma unroll
            for (int q = 0; q < 2; ++q) { const int item = tid + 512 * q, pp = item >> 4, n8 = (item & 15) * 8;
                *(uint4*)(PV + pp * 136 + n8) = *(const uint4*)(ST + ((size_t)(b * 128 + c) * 12 + hh) * 8192 + pp * 128 + n8); }
            __syncthreads();
            bf16_t zr[16];
#pragma unroll
            for (int reg = 0; reg < 16; ++reg) zr[reg] = Pb[(size_t)(t0 + li * 32 + 4 * hf + (reg & 3) + 8 * (reg >> 2)) * PP + 256 + hh * 64 + p];
            f32x16_t ad, ao;
#pragma unroll
            for (int q = 0; q < 16; ++q) { ad[q] = 0.f; ao[q] = 0.f; }
            const int nks = (li + 1) * 2;
#pragma unroll
            for (int ks = 0; ks < 8; ++ks) { const int k = ks * 16 + 8 * hf;
                if (ks < nks) { const bf16x8_t fa = *(const bf16x8_t*)(Mb + (li * 32 + l31) * 136 + k), fb = *(const bf16x8_t*)(XT + (pi * 32 + l31) * 136 + k); ad = __builtin_amdgcn_mfma_f32_32x32x16_bf16(fa, fb, ad, 0, 0, 0); }
                const bf16x8_t ga = *(const bf16x8_t*)(Cm + (li * 32 + l31) * 136 + k), gb = *(const bf16x8_t*)(PV + (pi * 32 + l31) * 136 + k); ao = __builtin_amdgcn_mfma_f32_32x32x16_bf16(ga, gb, ao, 0, 0, 0); }
            const float dk = dsk[hh];
#pragma unroll
            for (int reg = 0; reg < 16; ++reg) { const int rl_ = li * 32 + 4 * hf; const int row = rl_ + (reg & 3) + 8 * (reg >> 2);
                const float el = __expf(cumL[row]), xlp = bf2f(XT[p * 136 + row]);
                float y = ad[reg] + el * ao[reg] + dk * xlp;
                y *= siluf_(bf2f(zr[reg]));
                ssq[reg] += y * y;
                YM[(size_t)(t0 + row) * DM + 256 + g * 384 + e * 64 + p] = f2bf(y); }
        }
#pragma unroll
        for (int reg = 0; reg < 16; ++reg) { const int row = li * 32 + 4 * hf + (reg & 3) + 8 * (reg >> 2); const float s = half32_sum(ssq[reg]); if (l31 == 0) SSQ[row * 2 + pi] = s; }
        __syncthreads();
#pragma unroll
        for (int reg = 0; reg < 16; ++reg) { const int row = li * 32 + 4 * hf + (reg & 3) + 8 * (reg >> 2); ssq[reg] = rsqrtf((SSQ[row * 2] + SSQ[row * 2 + 1]) * (1.0f / 384.0f) + 1e-6f); }
#pragma unroll 1
        for (int e = 0; e < 6; ++e) { const float gn = ng[g * 384 + e * 64 + p]; bf16_t* yb = YM + (size_t)(t0 + li * 32 + 4 * hf) * DM + 256 + g * 384 + e * 64 + p; bf16_t yv[16];
#pragma unroll
            for (int reg = 0; reg < 16; ++reg) yv[reg] = yb[(size_t)((reg & 3) + 8 * (reg >> 2)) * DM];
#pragma unroll
            for (int reg = 0; reg < 16; ++reg) yb[(size_t)((reg & 3) + 8 * (reg >> 2)) * DM] = f2bf(bf2f(yv[reg]) * ssq[reg] * gn); }
    }
}

__device__ void phase_odd_prep(const Ctx& P, int layer, unsigned char* shm, bool dry = false) {
    const int i = layer >> 1, tid = ltid(), wave = __builtin_amdgcn_readfirstlane(tid >> 6), lane = tid & 63;
    const int bid = lbid(), nblk = lnb(), h = bid & 7;
    bf16_t* Pb = (bf16_t*)(P.ws + WS_P); bf16_t* YM = (bf16_t*)P.out;
    float* SCW = (float*)(P.ws + WS_SC + SC_W); bf16_t* SCKK = (bf16_t*)(P.ws + WS_SC + SC_KK); bf16_t* SCB = (bf16_t*)(P.ws + WS_SC + SC_B);
    const bf16_t* BND = (const bf16_t*)(P.ws + WS_MISC + MS_BND); float2* AGG = (float2*)(P.ws + WS_MISC + MS_AGG); float* BS = (float*)(P.ws + WS_MISC + MS_BS);
    bf16_t* WU = (bf16_t*)shm;
    bf16_t* AU = WU + 64 * 72;
    bf16_t* GU = AU + 64 * 72;
    bf16_t* WA = GU + 64 * 136;
    bf16_t* WX = WA + 64 * 72;
    bf16_t* AT = WX + 64 * 72;
    bf16_t* AA = AT + 128 * 72;
    bf16_t* AG = AA + 128 * 72;
    bf16_t* AX = AG + 128 * 136;
    float* RED = (float*)(AX + 128 * 72);
    float* AGL = RED + 512;
    bf16_t* RKV = AT;
    const float* mu = P.in[19] + i * 1792;
    const float* w_up = P.in[21] + (size_t)i * 64 * 512; const float* a_up = P.in[23] + (size_t)i * 64 * 512; const float* g_up = P.in[24] + (size_t)i * 128 * 512;
    const float* lcw = P.in[30] + i * 4 * 512; const float* lcb = P.in[31] + i * 512;
    const float* wa = P.in[32] + (size_t)i * 8 * 64 * 64; const float* wx = P.in[34] + (size_t)i * 8 * 64 * 64;
#pragma unroll
    for (int q = 0; q < 8; ++q) { const int e = tid + 512 * q, k = e >> 6, n = e & 63;
        WU[n * 72 + k] = f2bf(w_up[k * 512 + h * 64 + n]); AU[n * 72 + k] = f2bf(a_up[k * 512 + h * 64 + n]);
        WA[n * 72 + k] = f2bf(wa[(h * 64 + k) * 64 + n]); WX[n * 72 + k] = f2bf(wx[(h * 64 + k) * 64 + n]); }
#pragma unroll
    for (int q = 0; q < 16; ++q) { const int e = tid + 512 * q, k = e >> 6, n = e & 63; GU[n * 136 + k] = f2bf(g_up[k * 512 + h * 64 + n]); }
    const int tb = wave >> 1, nb = wave & 1, n = nb * 32 + (lane & 31), hf = lane >> 5, c = h * 64 + n;
    const float mu_r = mu[c], mu_k = mu[512 + c], mu_v = mu[1024 + c];
    const float w0 = P.in[20][i * 512 + c], a0 = P.in[22][i * 512 + c], k_k = P.in[25][i * 512 + c], k_a = P.in[26][i * 512 + c], r_k = P.in[27][i * 512 + c];
    const float ba = P.in[33][i * 512 + c], bx = P.in[35][i * 512 + c], sp = softplusf_(-P.in[36][i * 512 + c]);
    for (int tile = bid >> 3; tile < 256; tile += nblk >> 3) {
        const int t0 = tile * 128; const bool first = (t0 & (SEQ - 1)) == 0;
        __syncthreads();
#pragma unroll 4
        for (int q = 0; q < 8; ++q) { const int item = tid + 512 * q, t = item >> 5, cg = item & 31; const size_t tg = (size_t)t0 + t;
            const uint4 raw = *(const uint4*)(Pb + tg * PP + 1536 + cg * 8);
            uint4 prv; prv.x = 0u; prv.y = 0u; prv.z = 0u; prv.w = 0u; if ((tg & (SEQ - 1)) != 0) prv = *(const uint4*)(Pb + (tg - 1) * PP + 1536 + cg * 8);
            float a[8], p[8]; unpack8(raw, a); unpack8(prv, p);
            const float4 m0 = *(const float4*)(mu + 1536 + cg * 8), m1 = *(const float4*)(mu + 1536 + cg * 8 + 4); const float mm[8] = {m0.x, m0.y, m0.z, m0.w, m1.x, m1.y, m1.z, m1.w};
#pragma unroll
            for (int e = 0; e < 8; ++e) { const float s = a[e] + mm[e] * (p[e] - a[e]); a[e] = cg < 8 ? tanhf_(s) : (cg < 16 ? s : sigmoidf_(s)); }
            bf16_t* dst = cg < 8 ? AT + t * 72 + cg * 8 : (cg < 16 ? AA + t * 72 + (cg - 8) * 8 : AG + t * 136 + (cg - 16) * 8);
            *(uint4*)dst = pack8(a); }
#pragma unroll
        for (int q = 0; q < 2; ++q) { const int item = tid + 512 * q, t = item >> 3, cg = item & 7, cc = h * 64 + cg * 8;
            float acc[8]; { const float4 b0 = *(const float4*)(lcb + cc), b1 = *(const float4*)(lcb + cc + 4); acc[0] = b0.x; acc[1] = b0.y; acc[2] = b0.z; acc[3] = b0.w; acc[4] = b1.x; acc[5] = b1.y; acc[6] = b1.z; acc[7] = b1.w; }
#pragma unroll
            for (int d = 0; d < 4; ++d) { const int tr = t - d; uint4 raw; raw.x = 0u; raw.y = 0u; raw.z = 0u; raw.w = 0u;
                if (tr >= 0) raw = *(const uint4*)(Pb + ((size_t)t0 + tr) * PP + 2304 + cc);
                else if (!first) raw = *(const uint4*)(BND + ((size_t)(tile - 1) * 3 + 3 + tr) * PP + 2304 + cc);
                float x[8]; unpack8(raw, x); const float4 w0v = *(const float4*)(lcw + (3 - d) * 512 + cc), w1v = *(const float4*)(lcw + (3 - d) * 512 + cc + 4);
                acc[0] += w0v.x * x[0]; acc[1] += w0v.y * x[1]; acc[2] += w0v.z * x[2]; acc[3] += w0v.w * x[3]; acc[4] += w1v.x * x[4]; acc[5] += w1v.y * x[5]; acc[6] += w1v.z * x[6]; acc[7] += w1v.w * x[7]; }
            *(uint4*)(AX + t * 72 + cg * 8) = pack8(acc); }
        __syncthreads();
        f32x16_t cw_, ca_, cg_, cr_, ci_;
#pragma unroll
        for (int e = 0; e < 16; ++e) { cw_[e] = 0.f; ca_[e] = 0.f; cg_[e] = 0.f; cr_[e] = 0.f; ci_[e] = 0.f; }
        { const int ar = tb * 32 + (lane & 31), bn = nb * 32 + (lane & 31), ko = 8 * hf;
#pragma unroll
          for (int ks = 0; ks < 4; ++ks) { const int k = ks * 16 + ko;
              const bf16x8_t fa = *(const bf16x8_t*)(AT + ar * 72 + k), fb = *(const bf16x8_t*)(WU + bn * 72 + k); cw_ = __builtin_amdgcn_mfma_f32_32x32x16_bf16(fa, fb, cw_, 0, 0, 0);
              const bf16x8_t ga = *(const bf16x8_t*)(AA + ar * 72 + k), gb = *(const bf16x8_t*)(AU + bn * 72 + k); ca_ = __builtin_amdgcn_mfma_f32_32x32x16_bf16(ga, gb, ca_, 0, 0, 0);
              const bf16x8_t xa = *(const bf16x8_t*)(AX + ar * 72 + k), xb1 = *(const bf16x8_t*)(WA + bn * 72 + k), xb2 = *(const bf16x8_t*)(WX + bn * 72 + k);
              cr_ = __builtin_amdgcn_mfma_f32_32x32x16_bf16(xa, xb1, cr_, 0, 0, 0); ci_ = __builtin_amdgcn_mfma_f32_32x32x16_bf16(xa, xb2, ci_, 0, 0, 0); }
#pragma unroll
          for (int ks = 0; ks < 8; ++ks) { const int k = ks * 16 + ko; const bf16x8_t fa = *(const bf16x8_t*)(AG + ar * 136 + k), fb = *(const bf16x8_t*)(GU + bn * 136 + k); cg_ = __builtin_amdgcn_mfma_f32_32x32x16_bf16(fa, fb, cg_, 0, 0, 0); } }
        __syncthreads();
#pragma unroll
        for (int q = 0; q < 7; ++q) { const int item = tid + 512 * q; if (item < 129 * 32) { const int rr = item >> 5, part = item & 31, arr = part >> 3, cg = part & 7;
            const int col = (arr < 3 ? arr * 512 : 1792) + h * 64 + cg * 8;
            uint4 raw; raw.x = 0u; raw.y = 0u; raw.z = 0u; raw.w = 0u;
            if (rr > 0) raw = *(const uint4*)(Pb + ((size_t)t0 + rr - 1) * PP + col);
            else if (!first) raw = *(const uint4*)(BND + ((size_t)(tile - 1) * 3 + 2) * PP + col);
            *(uint4*)(RKV + rr * 264 + arr * 64 + cg * 8) = raw; } }
        for (int item = tid + 512 * 7; item < 129 * 32; item += 512) { const int rr = item >> 5, part = item & 31, arr = part >> 3, cg = part & 7;
            const int col = (arr < 3 ? arr * 512 : 1792) + h * 64 + cg * 8;
            *(uint4*)(RKV + rr * 264 + arr * 64 + cg * 8) = *(const uint4*)(Pb + ((size_t)t0 + rr - 1) * PP + col); }
        __syncthreads();
#pragma unroll
        for (int reg = 0; reg < 16; ++reg) { int rl_ = tb * 32 + 4 * hf; asm volatile("" : "+v"(rl_)); const int row = rl_ + (reg & 3) + 8 * (reg >> 2);
            const float rr_ = bf2f(RKV[(row + 1) * 264 + n]), rk_ = bf2f(RKV[(row + 1) * 264 + 64 + n]), pr_ = bf2f(RKV[row * 264 + n]), pk_ = bf2f(RKV[row * 264 + 64 + n]);
            const float rs = rr_ + mu_r * (pr_ - rr_), ks = rk_ + mu_k * (pk_ - rk_);
            const float a = sigmoidf_(a0 + ca_[reg]); const float kk = ks * k_k, k2 = ks * (1.0f + (a - 1.0f) * k_a);
            const float ss = half32_sum(kk * kk), bsum = half32_sum(rs * k2 * r_k);
            if ((lane & 31) == 0) { RED[(row * 2 + nb) * 2] = ss; RED[(row * 2 + nb) * 2 + 1] = bsum; }
            }
        __syncthreads();
        float segL[4], segH[4];
#pragma unroll
        for (int reg = 0; reg < 16; ++reg) { int rl_ = tb * 32 + 4 * hf; asm volatile("" : "+v"(rl_)); const int row = rl_ + (reg & 3) + 8 * (reg >> 2); const size_t t = (size_t)t0 + row; bf16_t* prow = Pb + t * PP;
            const float rr_ = bf2f(RKV[(row + 1) * 264 + n]), rk_ = bf2f(RKV[(row + 1) * 264 + 64 + n]), rv_ = bf2f(RKV[(row + 1) * 264 + 128 + n]);
            const float pr_ = bf2f(RKV[row * 264 + n]), pk_ = bf2f(RKV[row * 264 + 64 + n]), pv_ = bf2f(RKV[row * 264 + 128 + n]);
            const float rs = rr_ + mu_r * (pr_ - rr_), ks = rk_ + mu_k * (pk_ - rk_), vs = rv_ + mu_v * (pv_ - rv_);
            const float wl = -softplusf_(-(w0 + cw_[reg])) - 0.5f; const float wdec = __expf(-__expf(wl));
            const float a = sigmoidf_(a0 + ca_[reg]); const float kk = ks * k_k, k2 = ks * (1.0f + (a - 1.0f) * k_a);
            const float ss = RED[(row * 2) * 2] + RED[(row * 2 + 1) * 2]; const float kkn = kk * rsqrtf(ss + 1e-12f), bq = kkn * a;
            if (nb == 0 && (lane & 31) == 0) BS[t * 8 + h] = RED[(row * 2) * 2 + 1] + RED[(row * 2 + 1) * 2 + 1];
            const float gtv = bf2f(RKV[(row + 1) * 264 + 192 + n]);
            bf16_t* pst = dry ? (bf16_t*)(P.ws + WS_SC + 192 * MiB) + (t & 8191) * PP : prow;
            pst[c] = f2bf(rs); pst[512 + c] = f2bf(k2); pst[1024 + c] = f2bf(vs);
            SCW[t * 512 + c] = wdec; SCKK[t * 512 + c] = f2bf(kkn); SCB[t * 512 + c] = f2bf(bq); YM[t * DM + c] = f2bf(cg_[reg]);
            const float rg = sigmoidf_(cr_[reg] + ba), ig = sigmoidf_(ci_[reg] + bx); const float la = -8.0f * rg * sp; const bf16_t la_b = f2bf(la); const float la_r = bf2f(la_b);
            const float mult = __builtin_sqrtf(fmaxf(1.0f - __expf(2.0f * la), 0.f)); const float bl = mult * ig * bf2f(AX[row * 72 + n]); const bf16_t bl_b = f2bf(bl);
            YM[t * DM + 512 + c] = f2bf(gelu_tanh_(gtv)); pst[1792 + c] = la_b; pst[2304 + c] = bl_b;
            if ((reg & 3) == 0) { segL[reg >> 2] = la_r; segH[reg >> 2] = bf2f(bl_b); } else { segL[reg >> 2] += la_r; segH[reg >> 2] = __expf(la_r) * segH[reg >> 2] + bf2f(bl_b); }
            }
        { float L = 0.f, H = 0.f;
#pragma unroll
          for (int r = 0; r < 4; ++r) { const float oL = __shfl_xor(segL[r], 32), oH = __shfl_xor(segH[r], 32);
              const float L0 = hf ? oL : segL[r], H0 = hf ? oH : segH[r], L1 = hf ? segL[r] : oL, H1 = hf ? segH[r] : oH;
              H = __expf(L0) * H + H0; L += L0; H = __expf(L1) * H + H1; L += L1; }
          if (hf == 0) { AGL[(tb * 64 + n) * 2] = L; AGL[(tb * 64 + n) * 2 + 1] = H; } }
        __syncthreads();
        if (tid < 64) { float L = 0.f, H = 0.f;
#pragma unroll
            for (int r = 0; r < 4; ++r) { const float Ls = AGL[(r * 64 + tid) * 2], Hs = AGL[(r * 64 + tid) * 2 + 1]; H = __expf(Ls) * H + Hs; L += Ls; }
            AGG[tile * 512 + h * 64 + tid] = make_float2(L, H); }
    }
}

#define RING_BAR() do { asm volatile("s_waitcnt lgkmcnt(0)" ::: "memory"); __builtin_amdgcn_s_barrier(); asm volatile("" ::: "memory"); } while (0)
struct ScanStep { float4 w; uint2 kk, bb, kv, rv; float vv; };
__device__ void phase_odd_scan(const Ctx& P, unsigned char* shm) {
    const int tid = ltid(), wave = __builtin_amdgcn_readfirstlane(tid >> 6), lane = tid & 63;
    bf16_t* Pb = (bf16_t*)(P.ws + WS_P); bf16_t* YM = (bf16_t*)P.out;
    const float2* AGG = (const float2*)(P.ws + WS_MISC + MS_AGG);
    for (int task = lbid() * 8 + wave; task < 2048; task += lnb() * 8) {
        const int tile = task >> 3, c = (task & 7) * 64 + lane;
        float h = 0.f;
        {
            int i = tile & ~127;
            for (; i + 16 <= tile; i += 16) { float2 ag[16];
#pragma unroll
                for (int q = 0; q < 16; ++q) ag[q] = AGG[(i + q) * 512 + c];
#pragma unroll
                for (int q = 0; q < 16; ++q) h = __expf(ag[q].x) * h + ag[q].y; }
            for (; i < tile; ++i) { const float2 ag = AGG[i * 512 + c]; h = __expf(ag.x) * h + ag.y; }
        }
        {
            bf16_t la[16], bl[16], gg[16], la2[16], bl2[16], gg2[16];
#pragma unroll
            for (int q = 0; q < 16; ++q) { const size_t t = (size_t)tile * 128 + q; la[q] = Pb[t * PP + 1792 + c]; bl[q] = Pb[t * PP + 2304 + c]; gg[q] = YM[t * DM + 512 + c]; }
            for (int tb = 0; tb < 128; tb += 16) {
                const int tn = tb + 16 < 128 ? tb + 16 : tb;
#pragma unroll
                for (int q = 0; q < 16; ++q) { const size_t t = (size_t)tile * 128 + tn + q; la2[q] = Pb[t * PP + 1792 + c]; bl2[q] = Pb[t * PP + 2304 + c]; gg2[q] = YM[t * DM + 512 + c]; }
#pragma unroll
                for (int q = 0; q < 16; ++q) { const size_t t = (size_t)tile * 128 + tb + q; h = __expf(bf2f(la[q])) * h + bf2f(bl[q]); YM[t * DM + 512 + c] = f2bf(h * bf2f(gg[q])); }
#pragma unroll
                for (int q = 0; q < 16; ++q) { la[q] = la2[q]; bl[q] = bl2[q]; gg[q] = gg2[q]; }
            }
        }
    }
    __syncthreads();
#ifdef SCAN_TWICE
    for (int rep_ = 0; rep_ < 2; ++rep_)
#endif
    {
        typedef float f32x2 __attribute__((ext_vector_type(2)));
        const float* __restrict__ SCW = (const float*)(P.ws + WS_SC + SC_W); const bf16_t* __restrict__ SCKK = (const bf16_t*)(P.ws + WS_SC + SC_KK); const bf16_t* __restrict__ SCB = (const bf16_t*)(P.ws + WS_SC + SC_B);
        float* SCY = (float*)(P.ws + WS_SC + SC_Y);
        constexpr int CH = 32, NCH = SEQ / CH, BUFF = 16384;
        float* ring = (float*)shm;
        for (int task = lbid(); task < 256; task += lnb()) {
            const int xcd = task & 7, slot = task >> 3, bh = xcd * 2 + (slot >> 4), b = bh >> 3, hd = bh & 7, v0 = (slot & 15) * 4;
            const size_t tokb = (size_t)b * SEQ;
            if (wave != 0) {
                const int role = wave - 1;
                uint4 ra[4], rb[4];
#define RW_ISSUE(r, t0_) do { \
                    if (role < 2) { _Pragma("unroll") for (int i_ = 0; i_ < 4; ++i_) { const int idx_ = role * 256 + i_ * 64 + lane; const size_t tk_ = tokb + (t0_) + (idx_ >> 4); r[i_] = *(const uint4*)(SCW + tk_ * 512 + hd * 64 + 4 * (idx_ & 15)); } } \
                    else if (role < 5) { const bf16_t* sb_ = role == 2 ? SCKK + hd * 64 : (role == 3 ? SCB + hd * 64 : Pb + hd * 64); const size_t pitch_ = role == 4 ? PP : 512; \
                        _Pragma("unroll") for (int i_ = 0; i_ < 4; ++i_) { const int ia_ = (2 * i_) * 64 + lane, ib_ = (2 * i_ + 1) * 64 + lane; \
                            const uint2 a_ = *(const uint2*)(sb_ + (tokb + (t0_) + (ia_ >> 4)) * pitch_ + 4 * (ia_ & 15)), c_ = *(const uint2*)(sb_ + (tokb + (t0_) + (ib_ >> 4)) * pitch_ + 4 * (ib_ & 15)); \
                            r[i_].x = a_.x; r[i_].y = a_.y; r[i_].z = c_.x; r[i_].w = c_.y; } } \
                    else { _Pragma("unroll") for (int i_ = 0; i_ < 4; ++i_) { const int idx_ = (role - 5) * 256 + i_ * 64 + lane; const bf16_t* row_ = Pb + (tokb + (t0_) + (idx_ >> 4)) * PP + hd * 64; \
                            const uint2 a_ = *(const uint2*)(row_ + 512 + 4 * (idx_ & 15)), c_ = *(const uint2*)(row_ + 1024 + v0); r[i_].x = a_.x; r[i_].y = a_.y; r[i_].z = c_.x; r[i_].w = c_.y; } } } while (0)
#define RW_COMMIT(r, buf_) do { float* base_ = ring + (buf_) * BUFF; \
                    if (role < 2) { _Pragma("unroll") for (int i_ = 0; i_ < 4; ++i_) { const int idx_ = role * 256 + i_ * 64 + lane; *(uint4*)(base_ + (idx_ >> 4) * 64 + 4 * (idx_ & 15)) = r[i_]; } } \
                    else if (role < 5) { float* ab_ = base_ + 2048 * (role - 1); \
                        _Pragma("unroll") for (int i_ = 0; i_ < 4; ++i_) { const int ia_ = (2 * i_) * 64 + lane, ib_ = (2 * i_ + 1) * 64 + lane; float4 o_; \
                            o_.x = bflo(r[i_].x); o_.y = bfhi(r[i_].x); o_.z = bflo(r[i_].y); o_.w = bfhi(r[i_].y); *(float4*)(ab_ + (ia_ >> 4) * 64 + 4 * (ia_ & 15)) = o_; \
                            o_.x = bflo(r[i_].z); o_.y = bfhi(r[i_].z); o_.z = bflo(r[i_].w); o_.w = bfhi(r[i_].w); *(float4*)(ab_ + (ib_ >> 4) * 64 + 4 * (ib_ & 15)) = o_; } } \
                    else { _Pragma("unroll") for (int i_ = 0; i_ < 4; ++i_) { const int idx_ = (role - 5) * 256 + i_ * 64 + lane; float* d_ = base_ + 8192 + (idx_ >> 4) * 256 + 4 * (idx_ & 15); \
                            const float k0_ = bflo(r[i_].x), k1_ = bfhi(r[i_].x), k2_ = bflo(r[i_].y), k3_ = bfhi(r[i_].y), va_ = bflo(r[i_].z), vb_ = bfhi(r[i_].z), vc_ = bflo(r[i_].w), vd_ = bfhi(r[i_].w); float4 t_; \
                            t_.x = k0_ * va_; t_.y = k1_ * va_; t_.z = k2_ * va_; t_.w = k3_ * va_; *(float4*)d_ = t_; \
                            t_.x = k0_ * vb_; t_.y = k1_ * vb_; t_.z = k2_ * vb_; t_.w = k3_ * vb_; *(float4*)(d_ + 64) = t_; \
                            t_.x = k0_ * vc_; t_.y = k1_ * vc_; t_.z = k2_ * vc_; t_.w = k3_ * vc_; *(float4*)(d_ + 128) = t_; \
                            t_.x = k0_ * vd_; t_.y = k1_ * vd_; t_.z = k2_ * vd_; t_.w = k3_ * vd_; *(float4*)(d_ + 192) = t_; } } } while (0)
                RW_ISSUE(ra, 0); RW_COMMIT(ra, 0); RW_ISSUE(rb, CH); RW_ISSUE(ra, 2 * CH);
                RING_BAR();
                for (int ci = 0; ci < NCH; ci += 2) {
                    RW_COMMIT(rb, 1); if (ci + 3 < NCH) RW_ISSUE(rb, (ci + 3) * CH);
                    RING_BAR();
                    if (ci + 2 < NCH) { RW_COMMIT(ra, 0); if (ci + 4 < NCH) RW_ISSUE(ra, (ci + 4) * CH); }
                    RING_BAR();
                }
#undef RW_ISSUE
#undef RW_COMMIT
            } else {
                const int q = lane >> 4, j = lane & 15;
                f32x2 s01 = {0.f, 0.f}, s23 = {0.f, 0.f};
                const bool odd1 = (j & 1) != 0, odd2 = (j & 2) != 0; const int jq = j >> 2;
                float* yout = SCY + tokb * 512 + hd * 64 + v0 + (size_t)(4 * (j >> 2) + 2 * (j & 1) + ((j >> 1) & 1)) * 512 + q;
                RING_BAR();
                for (int ci = 0; ci < NCH; ++ci) {
                    const float* B = ring + (ci & 1) * BUFF;
                    float4 Lw[3], Lkk[3], Lbb[3], Lrv[3], Lvk[3];
#define SC_LD(sl_, u_) do { Lw[sl_] = *(const float4*)(B + (u_) * 64 + 4 * j); Lkk[sl_] = *(const float4*)(B + 2048 + (u_) * 64 + 4 * j); Lbb[sl_] = *(const float4*)(B + 4096 + (u_) * 64 + 4 * j); \
                        Lrv[sl_] = *(const float4*)(B + 6144 + (u_) * 64 + 4 * j); Lvk[sl_] = *(const float4*)(B + 8192 + (u_) * 256 + q * 64 + 4 * j); } while (0)
                    SC_LD(0, 0); SC_LD(1, 1);
                    float yacc = 0.f, yp0 = 0.f, yp1 = 0.f, yp2 = 0.f, yp3 = 0.f;
#pragma unroll
                    for (int u = 0; u < 32; ++u) {
                        if (u + 2 < 32) SC_LD((u + 2) % 3, u + 2);
                        if (u > 0 && (u & 3) == 0) {
                            const float sa_ = odd1 ? yp2 : yp0, sb_ = odd1 ? yp3 : yp1, ta_ = odd1 ? yp0 : yp2, tb_ = odd1 ? yp1 : yp3;
                            const float n0 = sa_ + __builtin_bit_cast(float, __builtin_amdgcn_update_dpp(0, __builtin_bit_cast(int, ta_), 0xB1, 0xF, 0xF, true));
                            const float n1 = sb_ + __builtin_bit_cast(float, __builtin_amdgcn_update_dpp(0, __builtin_bit_cast(int, tb_), 0xB1, 0xF, 0xF, true));
                            const float sc_ = odd2 ? n1 : n0, tc_ = odd2 ? n0 : n1;
                            float m_ = sc_ + __builtin_bit_cast(float, __builtin_amdgcn_update_dpp(0, __builtin_bit_cast(int, tc_), 0x4E, 0xF, 0xF, true));
                            m_ += __builtin_bit_cast(float, __builtin_amdgcn_update_dpp(0, __builtin_bit_cast(int, m_), 0x128, 0xF, 0xF, true));
                            m_ += __builtin_bit_cast(float, __builtin_amdgcn_update_dpp(0, __builtin_bit_cast(int, m_), 0x124, 0xF, 0xF, true));
                            yacc = (jq == (((u - 4) >> 2) & 3)) ? m_ : yacc;
                            if ((u & 15) == 0) yout[(size_t)(ci * CH + (u - 16)) * 512] = yacc; }
                        const float4 w = Lw[u % 3], kk = Lkk[u % 3], bb = Lbb[u % 3], rv = Lrv[u % 3], vk = Lvk[u % 3];
                        const f32x2 kk01 = {kk.x, kk.y}, kk23 = {kk.z, kk.w}, bb01 = {bb.x, bb.y}, bb23 = {bb.z, bb.w}, vk01 = {vk.x, vk.y}, vk23 = {vk.z, vk.w}, w01 = {w.x, w.y}, w23 = {w.z, w.w}, r01 = {rv.x, rv.y}, r23 = {rv.z, rv.w};
                        const f32x2 q01 = s01 * w01 + vk01, q23 = s23 * w23 + vk23;
                        f32x2 d2 = s01 * kk01; d2 = s23 * kk23 + d2;
                        float dot = d2.x + d2.y; dot = row16_sum(dot);
                        const f32x2 sa2 = {-dot, -dot};
                        s01 = sa2 * bb01 + q01;
                        s23 = sa2 * bb23 + q23;
                        f32x2 y2 = s01 * r01; y2 = s23 * r23 + y2;
                        const float ypn = y2.x + y2.y;
                        if ((u & 3) == 0) yp0 = ypn; else if ((u & 3) == 1) yp1 = ypn; else if ((u & 3) == 2) yp2 = ypn; else yp3 = ypn;
                    }
                    {
                        const float sa_ = odd1 ? yp2 : yp0, sb_ = odd1 ? yp3 : yp1, ta_ = odd1 ? yp0 : yp2, tb_ = odd1 ? yp1 : yp3;
                        const float n0 = sa_ + __builtin_bit_cast(float, __builtin_amdgcn_update_dpp(0, __builtin_bit_cast(int, ta_), 0xB1, 0xF, 0xF, true));
                        const float n1 = sb_ + __builtin_bit_cast(float, __builtin_amdgcn_update_dpp(0, __builtin_bit_cast(int, tb_), 0xB1, 0xF, 0xF, true));
                        const float sc_ = odd2 ? n1 : n0, tc_ = odd2 ? n0 : n1;
                        float m_ = sc_ + __builtin_bit_cast(float, __builtin_amdgcn_update_dpp(0, __builtin_bit_cast(int, tc_), 0x4E, 0xF, 0xF, true));
                        m_ += __builtin_bit_cast(float, __builtin_amdgcn_update_dpp(0, __builtin_bit_cast(int, m_), 0x128, 0xF, 0xF, true));
                        m_ += __builtin_bit_cast(float, __builtin_amdgcn_update_dpp(0, __builtin_bit_cast(int, m_), 0x124, 0xF, 0xF, true));
                        yacc = (jq == 3) ? m_ : yacc;
                        yout[(size_t)(ci * CH + 16) * 512] = yacc; }
#undef SC_LD
                    RING_BAR();
                }
            }
        }
    }
}

__device__ __forceinline__ float oct_sum(float x) {
    x += __builtin_bit_cast(float, __builtin_amdgcn_update_dpp(0, __builtin_bit_cast(int, x), 0xB1, 0xF, 0xF, true));
    x += __builtin_bit_cast(float, __builtin_amdgcn_update_dpp(0, __builtin_bit_cast(int, x), 0x4E, 0xF, 0xF, true));
    x += __builtin_bit_cast(float, __builtin_amdgcn_update_dpp(0, __builtin_bit_cast(int, x), 0x141, 0xF, 0xF, true));
    return x;
}
__device__ void phase_odd_post(const Ctx& P, int layer) {
    const int i = layer >> 1, tid = ltid(), lane = tid & 63;
    const bf16_t* Pb = (const bf16_t*)(P.ws + WS_P); bf16_t* YM = (bf16_t*)P.out;
    const float* SCY = (const float*)(P.ws + WS_SC + SC_Y); const float* BS = (const float*)(P.ws + WS_MISC + MS_BS);
    const float* lng = P.in[28] + i * 512; const float* lnbias = P.in[29] + i * 512;
    const int c8 = lane * 8, hd = lane >> 3;
    float gw[8], gb[8];
    { const float4 a0 = *(const float4*)(lng + c8), a1 = *(const float4*)(lng + c8 + 4), b0 = *(const float4*)(lnbias + c8), b1 = *(const float4*)(lnbias + c8 + 4);
      gw[0] = a0.x; gw[1] = a0.y; gw[2] = a0.z; gw[3] = a0.w; gw[4] = a1.x; gw[5] = a1.y; gw[6] = a1.z; gw[7] = a1.w; gb[0] = b0.x; gb[1] = b0.y; gb[2] = b0.z; gb[3] = b0.w; gb[4] = b1.x; gb[5] = b1.y; gb[6] = b1.z; gb[7] = b1.w; }
    const int tstep = lnb() * 8; int t = lbid() * 8 + (tid >> 6);
    float4 y0, y1; uint4 vr, gr; float bs;
    if (t < M_TOK) { y0 = *(const float4*)(SCY + (size_t)t * 512 + c8); y1 = *(const float4*)(SCY + (size_t)t * 512 + c8 + 4); vr = *(const uint4*)(Pb + (size_t)t * PP + 1024 + c8); gr = *(const uint4*)(YM + (size_t)t * DM + c8); bs = BS[t * 8 + hd]; }
    for (; t < M_TOK; t += tstep) {
        const int tn = t + tstep < M_TOK ? t + tstep : t;
        const float4 ny0 = *(const float4*)(SCY + (size_t)tn * 512 + c8), ny1 = *(const float4*)(SCY + (size_t)tn * 512 + c8 + 4);
        const uint4 nvr = *(const uint4*)(Pb + (size_t)tn * PP + 1024 + c8), ngr = *(const uint4*)(YM + (size_t)tn * DM + c8); const float nbs = BS[tn * 8 + hd];
        float y[8] = {y0.x, y0.y, y0.z, y0.w, y1.x, y1.y, y1.z, y1.w}, v[8], g[8]; unpack8(vr, v); unpack8(gr, g);
        float s = 0.f;
#pragma unroll
        for (int e = 0; e < 8; ++e) s += y[e];
        const float mean = oct_sum(s) * (1.0f / 64.0f);
        float q = 0.f;
#pragma unroll
        for (int e = 0; e < 8; ++e) { y[e] -= mean; q += y[e] * y[e]; }
        const float rstd = rsqrtf(oct_sum(q) * (1.0f / 64.0f) + 64e-5f);
#pragma unroll
        for (int e = 0; e < 8; ++e) y[e] = (y[e] * rstd * gw[e] + gb[e] + bs * v[e]) * g[e];
        *(uint4*)(YM + (size_t)t * DM + c8) = pack8(y);
        y0 = ny0; y1 = ny1; vr = nvr; gr = ngr; bs = nbs;
    }
}

#define XB_TMO      128
#define XB_XCNT(j)  (256  + 64 * (j))
#define XB_XSUB(j)  (1280 + 64 * (j))
#define XB_XGEN(j)  (2304 + 64 * (j))
#define XB_TOP      3328
#define XB_TOPGEN   3392
#define XCD_BAR_WORDS 3456
#define XB_SPIN_CAP (1u << 18)

__device__ __forceinline__ unsigned xb_ld(unsigned* p)              { return __hip_atomic_load(p, __ATOMIC_RELAXED, __HIP_MEMORY_SCOPE_AGENT); }
__device__ __forceinline__ unsigned xb_add(unsigned* p, unsigned v) { return __hip_atomic_fetch_add(p, v, __ATOMIC_RELAXED, __HIP_MEMORY_SCOPE_AGENT); }
__device__ __forceinline__ unsigned xb_xcc_id() { return (unsigned)__builtin_amdgcn_s_getreg((3 << 11) | 20) & 0xFu; }
#define XB_SPIN(cond, bar) do { unsigned _sp = 0; while (cond) { __builtin_amdgcn_s_sleep(1); \
    if ((++_sp & 255u) == 0u) { if (xb_ld(&(bar)[XB_TMO])) break; if (_sp > XB_SPIN_CAP) { atomicAdd(&(bar)[XB_TMO], 1u); break; } } } } while (0)

struct XcdBarrier {
    unsigned* bar; unsigned x;
    volatile LAS unsigned* st;
};

__device__ __forceinline__ XcdBarrier xcd_barrier_post(unsigned* bar, volatile LAS unsigned* st) {
    XcdBarrier b; b.bar = bar; b.x = xb_xcc_id(); b.st = st;
    if (threadIdx.x == 0) (void)xb_add(&bar[XB_XCNT(b.x)], 1u);
    return b;
}
__device__ __forceinline__ void xcd_barrier_complete(unsigned* bar, unsigned x, unsigned& nloc, unsigned& nx) {
    const unsigned G = gridDim.x * gridDim.y * gridDim.z;
    unsigned sum, cnt, mine, sp = 0u;
    for (;;) {
        sum = 0u; cnt = 0u; mine = 0u;
#pragma unroll
        for (unsigned j = 0; j < 16; ++j) { const unsigned c = xb_ld(&bar[XB_XCNT(j)]); sum += c; cnt += (c > 0u) ? 1u : 0u; mine = (j == x) ? c : mine; }
        if (sum == G) break;
        __builtin_amdgcn_s_sleep(1);
        if ((++sp & 255u) == 0u) { if (xb_ld(&bar[XB_TMO])) break; if (sp > XB_SPIN_CAP) { atomicAdd(&bar[XB_TMO], 1u); break; } }
    }
    nloc = mine > 0u ? mine : 1u; nx = cnt > 0u ? cnt : 1u;
}

__device__ __forceinline__ void xcd_barrier(const XcdBarrier& b) {
    asm volatile("s_waitcnt vmcnt(0)" ::: "memory");
    __syncthreads();
    if (threadIdx.x == 0) {
        unsigned* bar = b.bar;
        __builtin_amdgcn_s_waitcnt(0);
        unsigned nloc = b.st[0], nx = b.st[1];
        if (nloc == 0u) { xcd_barrier_complete(bar, b.x, nloc, nx); b.st[0] = nloc; b.st[1] = nx; }
        const unsigned old = xb_add(&bar[XB_XSUB(b.x)], 1u);
        const unsigned gen = old / nloc;
        if (old + 1u == (gen + 1u) * nloc) {
            __builtin_amdgcn_fence(__ATOMIC_RELEASE, "agent");
            asm volatile("s_waitcnt vmcnt(0)" ::: "memory");
            const unsigned og = xb_add(&bar[XB_TOP], 1u);
            const unsigned tg = og / nx;
            if (og + 1u == (tg + 1u) * nx) xb_add(&bar[XB_TOPGEN], 1u);
            else XB_SPIN(xb_ld(&bar[XB_TOPGEN]) == tg, bar);
            __builtin_amdgcn_fence(__ATOMIC_ACQUIRE, "agent");
            xb_add(&bar[XB_XGEN(b.x)], 1u);
            asm volatile("s_waitcnt vmcnt(0)" ::: "memory");
        } else {
            XB_SPIN(xb_ld(&bar[XB_XGEN(b.x)]) == gen, bar);
            __builtin_amdgcn_fence(__ATOMIC_ACQUIRE, "agent");
            asm volatile("s_waitcnt vmcnt(0)" ::: "memory");
        }
    }
    __syncthreads();
}

#ifndef REPEAT_ODD
#define REPEAT_ODD -1
#endif
#ifndef SUBMASK
#define SUBMASK 0x3ff
#endif
#define EN(s) (((SUBMASK) >> (s)) & 1)
#ifndef PH_ODD_FORCE
#define PH_ODD_FORCE
#endif
constexpr int N_PHASES = 41;
__host__ __device__ inline bool phase_is_noop(int ph) { return ph < 40 && ((ph / 10) & 1) && (ph % 10) == 5; }

__device__ __forceinline__ void run_phase(const Ctx& P, int ph, unsigned char* shm) {
    bf16_t* HN = (bf16_t*)(P.ws + WS_HN); bf16_t* Pb = (bf16_t*)(P.ws + WS_P); bf16_t* HB2 = (bf16_t*)(P.ws + WS_SC + SC_HB2);
    float* SS1 = (float*)(P.ws + WS_SC + SC_SSP1); float* SS2 = (float*)(P.ws + WS_SC + SC_SSP2); float* RS1 = (float*)(P.ws + WS_MISC + MS_SS1); float* RS2 = (float*)(P.ws + WS_MISC + MS_SS2);
    if (ph == 40) { phase_final_norm(HN, P.out, P.in[6], SS1); return; }
    const int layer = ph / 10, sub = ph % 10; const bool odd = (layer & 1) PH_ODD_FORCE;
#ifdef ONLY_SUB
    if (sub != ONLY_SUB) return;
#endif
    switch (sub) {
    case 0: if (EN(0)) { phase_convert(P, layer, shm); if (layer == 0) phase_x_to_bf16(P.in[0], HN, RS1); else finalize_rstd(SS1, RS1);
#ifdef FILL_PROBE
              if (layer == 0) { uint4 z; z.x = 0u; z.y = 0u; z.z = 0u; z.w = 0u; uint4* fp = (uint4*)(P.ws + WS_SC + 128 * MiB); for (size_t i_ = (size_t)lbid() * 512 + ltid(); i_ < 80 * MiB / 16; i_ += (size_t)lnb() * 512) fp[i_] = z; }
#endif
            } break;
    case 1: if (EN(1)) { pg8::Gemm g{HN, (const bf16_t*)(P.ws + WS_WIN), M_TOK, odd ? 2816 : 2560, 1024}; pg8::StaticOrder S; S.init(g.M, g.N, lnb(), lbid());
              EpiP E{Pb, odd ? (bf16_t*)(P.ws + WS_MISC + MS_BND) : nullptr, RS1}; pg8::gemm_phase<EpiP, pg8::StaticOrder>((PG8_LAS unsigned char*)shm, g, S, E, nullptr); } break;
#ifdef DRY_ODD_PREP
    case 2: if (EN(2)) { if (odd) { phase_odd_prep(P, layer, shm, true); __syncthreads(); phase_odd_prep(P, layer, shm); } else phase_even_prep(P, layer); } break;
#else
    case 2: if (EN(2)) { if (odd) phase_odd_prep(P, layer, shm); else phase_even_prep(P, layer); } break;
#endif
    case 3: if (EN(3)) { if (odd) phase_odd_scan(P, shm); else phase_even_states(P, layer, shm); } break;
    case 4: if (EN(4)) { if (odd) phase_odd_post(P, layer); else phase_even_pass(P); } break;
    case 5: if (EN(5)) { if (!odd) phase_even_out(P, layer, shm); } break;
    case 6: if (EN(6)) { pg8::Gemm g{(const bf16_t*)P.out, (const bf16_t*)(P.ws + WS_WOUT), M_TOK, 1024, 1024}; pg8::StaticOrder S; S.init(g.M, g.N, lnb(), lbid());
              EpiRes E{HN, HB2, SS2}; pg8::gemm_phase<EpiRes, pg8::StaticOrder>((PG8_LAS unsigned char*)shm, g, S, E, nullptr); } break;
    case 7: if (EN(7)) finalize_rstd(SS2, RS2); break;
    case 8: if (EN(8)) { pg8::Gemm g{HB2, (const bf16_t*)(P.ws + WS_WGU), M_TOK, 5632, 1024}; pg8::StaticOrder S; S.init(g.M, g.N, lnb(), lbid());
              EpiSwi E{Pb, RS2}; pg8::gemm_phase<EpiSwi, pg8::StaticOrder>((PG8_LAS unsigned char*)shm, g, S, E, nullptr); } break;
    case 9: if (EN(9)) {
#ifdef STAGGER_US
              if (lbid() & 4) { const unsigned long long t0_ = __builtin_amdgcn_s_memrealtime(); while (__builtin_amdgcn_s_memrealtime() - t0_ < (unsigned long long)(STAGGER_US) * 100ull) __builtin_amdgcn_s_sleep(8); }
#endif
              pg8::Gemm g{Pb, (const bf16_t*)(P.ws + WS_WDN), M_TOK, 1024, 2816}; pg8::StaticOrder S; S.init(g.M, g.N, lnb(), lbid());
              EpiRes E{HB2, HN, SS1}; pg8::gemm_phase<EpiRes, pg8::StaticOrder>((PG8_LAS unsigned char*)shm, g, S, E, nullptr); } break;
    }
}

__global__ void __launch_bounds__(512, 2) k_main(Params P) {
    extern __shared__ __attribute__((aligned(16))) unsigned char shm[];
    cg::grid_group grid = cg::this_grid();
    volatile LAS unsigned* bst = (volatile LAS unsigned*)((LAS unsigned char*)shm + LDS_BYTES - 16);
    if (threadIdx.x < 2) bst[threadIdx.x] = 0u;
    __syncthreads();
    (void)xcd_barrier_post((unsigned*)(P.ws + WS_MISC + MS_BAR), bst);
    int nsync = 0;
#define GRID_BAR() do { int zb_ = 0; asm volatile("" : "+s"(zb_)); XcdBarrier bar_; bar_.bar = (unsigned*)(P.ws + zb_ + WS_MISC + MS_BAR); bar_.x = xb_xcc_id(); \
        bar_.st = (volatile LAS unsigned*)((LAS unsigned char*)shm + LDS_BYTES - 16); xcd_barrier(bar_); } while (0)
    bool first = true;
#ifdef EXTRA_SYNCS
    for (int es_ = 0; es_ < EXTRA_SYNCS; ++es_) GRID_BAR();
#endif
    for (int ph = P.ph_lo; ph < P.ph_hi; ++ph) {
        if (phase_is_noop(ph)) continue;
        if (!first) { if (nsync == 0) grid.sync(); else GRID_BAR(); nsync = 1; }
        first = false;
        int z = 0; asm volatile("" : "+s"(z));
        Ctx C; C.in.p = &P; C.in.z = z; C.out = P.out + z; C.ws = P.ws + z;
        run_phase(C, ph, shm);
#ifdef REPEAT_MASK
        if (ph < 40 && ((REPEAT_MASK >> (ph % 10)) & 1) && (REPEAT_ODD < 0 || ((ph / 10) & 1) == REPEAT_ODD)) { GRID_BAR(); run_phase(C, ph, shm); }
#endif

    }
}

#ifndef MK_ONE_LAUNCH
#define MK_ONE_LAUNCH 1
#endif
extern "C" void kernel_launch(void* const* d_in, const int* in_sizes, int n_in, void* d_out, int out_size, void* d_ws, size_t ws_size, hipStream_t stream) {
    static int state = 0;
    if (state == 0) {
        if (n_in != NIN || out_size != M_TOK * DM || ws_size < WS_END) { fprintf(stderr, "kernel_launch: unexpected shapes (n_in %d out %d ws %zu)\n", n_in, out_size, ws_size); state = -1; return; }
        if (hipFuncSetAttribute((const void*)k_main, hipFuncAttributeMaxDynamicSharedMemorySize, LDS_BYTES) != hipSuccess) { fprintf(stderr, "kernel_launch: hipFuncSetAttribute failed\n"); state = -1; return; }
        int dev = 0, cus = 0, per_cu = 0;
        if (hipGetDevice(&dev) != hipSuccess || hipDeviceGetAttribute(&cus, hipDeviceAttributeMultiprocessorCount, dev) != hipSuccess || cus < 8) { fprintf(stderr, "kernel_launch: cannot query the CU count\n"); state = -1; return; }
        if (hipOccupancyMaxActiveBlocksPerMultiprocessor(&per_cu, (const void*)k_main, 512, LDS_BYTES) != hipSuccess || per_cu < 1) fprintf(stderr, "kernel_launch: note: occupancy query reports %d workgroups per CU\n", per_cu);
        (void)hipGetLastError();
        state = (cus < 256 ? cus : 256) & ~7;
    }
    if (state < 0) return;
    if (hipMemsetAsync((unsigned char*)d_ws + WS_MISC + MS_BAR, 0, BAR_BYTES, stream) != hipSuccess) { fprintf(stderr, "kernel_launch: memset failed\n"); return; }
    Params p{};
    for (int i = 0; i < NIN; ++i) p.in[i] = (const float*)d_in[i];
    p.out = (float*)d_out; p.ws = (unsigned char*)d_ws;
#if MK_ONE_LAUNCH
    p.ph_lo = 0; p.ph_hi = N_PHASES;
    void* args[] = {&p};
    hipError_t e = hipLaunchCooperativeKernel((const void*)k_main, dim3(state), dim3(512), args, LDS_BYTES, stream);
    if (e != hipSuccess) fprintf(stderr, "cooperative launch failed: %s\n", hipGetErrorString(e));
#else
    for (int ph = 0; ph < N_PHASES; ++ph) { if (phase_is_noop(ph)) continue; p.ph_lo = ph; p.ph_hi = ph + 1; hipLaunchKernelGGL(k_main, dim3(state), dim3(512), LDS_BYTES, stream, p); }
#endif
}
```
